# Optimizing an MI355X kernel written in HIP

```python
import jax, jax.numpy as jnp
from jax import lax
import numpy as np

D_MODEL = 1024
BATCH = 4
SEQ = 8192
DEPTH = 2

HEAD_DIM = 64
N_HEADS_FOX = 4
DIL_PATTERNS = ((128, 1), (512, 4), (2048, 16))
N_DIL_GROUPS = 3
HEADS_PER_DIL = 2
N_HEADS_DIL = N_DIL_GROUPS * HEADS_PER_DIL
N_HEADS_MOBA = 6
N_HEADS = N_HEADS_FOX + N_HEADS_DIL + N_HEADS_MOBA
MIX_WIDTH = N_HEADS * HEAD_DIM
MOBA_BLOCK = 256
MOBA_TOPK = 3
MOBA_Q_CHUNK = 32
Q_BLOCK = 128
PLE_DIM = 256
D_FF = -(-8 * D_MODEL // (3 * 256)) * 256
ROPE_THETA = 10000.0
RMS_EPS = 1e-6
NEG_INF = -1e30
N_GATE_COLS = 3 * D_MODEL
W_IN_COLS = 3 * MIX_WIDTH + N_HEADS_FOX + N_GATE_COLS

kernel_name = "hybrid_fox_dilated_moba_block"


def rms_norm(x, g):
    xf = x.astype(jnp.float32)
    var = jnp.mean(xf * xf, axis=-1, keepdims=True)
    return (xf * lax.rsqrt(var + RMS_EPS) * g.astype(jnp.float32)).astype(x.dtype)


def rope_tables(seq):
    inv = 1.0 / (ROPE_THETA ** (jnp.arange(0, HEAD_DIM, 2, dtype=jnp.float32) / HEAD_DIM))
    ang = jnp.arange(seq, dtype=jnp.float32)[:, None] * inv[None, :]
    return jnp.cos(ang), jnp.sin(ang)


def apply_rope(x, cos, sin):
    xf = x.astype(jnp.float32)
    x1, x2 = jnp.split(xf, 2, axis=-1)
    c = cos[None, :, None, :]
    s = sin[None, :, None, :]
    return jnp.concatenate([x1 * c - x2 * s, x2 * c + x1 * s], axis=-1).astype(x.dtype)


def fox_attention(q, k, v, f_logit):
    B, S, H, D = q.shape
    scale = D ** -0.5
    c = jnp.cumsum(jax.nn.log_sigmoid(f_logit.astype(jnp.float32)), axis=1).transpose(0, 2, 1)
    kh = k.transpose(0, 2, 1, 3)
    vh = v.transpose(0, 2, 1, 3)
    nq = S // Q_BLOCK
    qb = q.reshape(B, nq, Q_BLOCK, H, D).transpose(1, 0, 3, 2, 4)
    cb = c.reshape(B, H, nq, Q_BLOCK).transpose(2, 0, 1, 3)
    key_pos = jnp.arange(S)

    def block(args):
        q_blk, c_blk, i = args
        s = jnp.einsum('bhqd,bhkd->bhqk', q_blk, kh).astype(jnp.float32) * scale
        s = s + c_blk[..., None] - c[:, :, None, :]
        qpos = i * Q_BLOCK + jnp.arange(Q_BLOCK)
        s = jnp.where(key_pos[None, :] <= qpos[:, None], s, NEG_INF)
        p = jax.nn.softmax(s, axis=-1).astype(v.dtype)
        return jnp.einsum('bhqk,bhkd->bhqd', p, vh)

    out = lax.map(block, (qb, cb, jnp.arange(nq)))
    return out.transpose(1, 0, 3, 2, 4).reshape(B, S, H * D)


def dilated_attention(q, k, v):
    B, S, _, D = q.shape
    G, Hg = N_DIL_GROUPS, HEADS_PER_DIL
    scale = D ** -0.5
    pad = max(w for w, _ in DIL_PATTERNS)
    qg = q.reshape(B, S, G, Hg, D)
    pad_spec = ((0, 0), (pad, 0), (0, 0), (0, 0), (0, 0))
    kg = jnp.pad(k.reshape(B, S, G, Hg, D), pad_spec)
    vg = jnp.pad(v.reshape(B, S, G, Hg, D), pad_spec)
    k_groups = [kg[:, :, g] for g in range(G)]
    v_groups = [vg[:, :, g] for g in range(G)]
    nq = S // Q_BLOCK

    def block(i):
        t0 = i * Q_BLOCK
        q_blk = lax.dynamic_slice_in_dim(qg, t0, Q_BLOCK, axis=1)
        qpos = t0 + jnp.arange(Q_BLOCK)
        outs, lses = [], []
        for g, (window, dil) in enumerate(DIL_PATTERNS):
            offs = dil * jnp.arange(window // dil + 1)
            kpos = qpos[:, None] - offs[None, :]
            k_sel = jnp.take(k_groups[g], kpos + pad, axis=1)
            v_sel = jnp.take(v_groups[g], kpos + pad, axis=1)
            s = jnp.einsum('bqhd,bqnhd->bqhn', q_blk[:, :, g], k_sel).astype(jnp.float32) * scale
            s = jnp.where((kpos >= 0)[None, :, None, :], s, NEG_INF)
            m = jnp.max(s, axis=-1, keepdims=True)
            e = jnp.exp(s - m)
            den = jnp.sum(e, axis=-1, keepdims=True)
            o = jnp.einsum('bqhn,bqnhd->bqhd', (e / den).astype(v.dtype), v_sel)
            outs.append(o)
            lses.append((m + jnp.log(den))[..., 0])
        wts = jax.nn.softmax(jnp.stack(lses, axis=0), axis=0)
        o = jnp.sum(wts[..., None] * jnp.stack(outs, axis=0).astype(jnp.float32), axis=0)
        return o.astype(v.dtype).reshape(B, Q_BLOCK, Hg * D)

    out = lax.map(block, jnp.arange(nq))
    return out.transpose(1, 0, 2, 3).reshape(B, S, Hg * D)


def moba_attention(q, k, v):
    B, S, H, D = q.shape
    L = MOBA_BLOCK
    scale = D ** -0.5
    nb = -(-S // L)
    s_pad = nb * L
    k_p = jnp.pad(k, ((0, 0), (0, s_pad - S), (0, 0), (0, 0)))
    v_p = jnp.pad(v, ((0, 0), (0, s_pad - S), (0, 0), (0, 0)))
    kb = k_p.reshape(B, nb, L, H, D).transpose(0, 3, 1, 2, 4)
    vb = v_p.reshape(B, nb, L, H, D).transpose(0, 3, 1, 2, 4)
    k_mean = jnp.mean(kb.astype(jnp.float32), axis=3).astype(k.dtype)
    n_sel = min(MOBA_TOPK, nb)
    b_idx = jnp.arange(B)[:, None, None, None]
    h_idx = jnp.arange(H)[None, :, None, None]
    nq = S // MOBA_Q_CHUNK

    def chunk(i):
        t0 = i * MOBA_Q_CHUNK
        q_c = lax.dynamic_slice_in_dim(q, t0, MOBA_Q_CHUNK, axis=1).transpose(0, 2, 1, 3)
        qpos = t0 + jnp.arange(MOBA_Q_CHUNK)
        own = t0 // L
        gate = jnp.einsum('bhqd,bhnd->bhqn', q_c, k_mean).astype(jnp.float32)
        gate = jnp.where(jnp.arange(nb) < own, gate, NEG_INF)
        _, sel = lax.top_k(gate, n_sel)
        sel_valid = sel < own
        k_sel = kb[b_idx, h_idx, sel]
        v_sel = vb[b_idx, h_idx, sel]
        s_sel = jnp.einsum('bhqd,bhqnld->bhqnl', q_c, k_sel).astype(jnp.float32) * scale
        s_sel = jnp.where(sel_valid[..., None], s_sel, NEG_INF)
        k_own = lax.dynamic_slice_in_dim(kb, own, 1, axis=2)[:, :, 0]
        v_own = lax.dynamic_slice_in_dim(vb, own, 1, axis=2)[:, :, 0]
        s_own = jnp.einsum('bhqd,bhld->bhql', q_c, k_own).astype(jnp.float32) * scale
        own_pos = own * L + jnp.arange(L)
        s_own = jnp.where(own_pos[None, :] <= qpos[:, None], s_own, NEG_INF)
        s_all = jnp.concatenate([s_sel.reshape(B, H, MOBA_Q_CHUNK, n_sel * L), s_own], axis=-1)
        p = jax.nn.softmax(s_all, axis=-1).astype(v.dtype)
        p_sel = p[..., : n_sel * L].reshape(B, H, MOBA_Q_CHUNK, n_sel, L)
        p_own = p[..., n_sel * L:]
        o = jnp.einsum('bhqnl,bhqnld->bhqd', p_sel, v_sel) + jnp.einsum('bhql,bhld->bhqd', p_own, v_own)
        return o.transpose(0, 2, 1, 3).reshape(B, MOBA_Q_CHUNK, H * D)

    out = lax.map(chunk, jnp.arange(nq))
    return out.transpose(1, 0, 2, 3).reshape(B, S, H * D)


def setup_inputs(seed: int = 0) -> dict:
    key = jax.random.key(seed)
    ks = jax.random.split(key, 20)
    f32 = jnp.float32

    def w(k, shape, fan_in):
        return jax.random.normal(k, shape, f32) * fan_in ** -0.5

    def gain(k):
        return 1.0 + 0.05 * jax.random.normal(k, (DEPTH, D_MODEL), f32)

    return {
        "x": jax.random.normal(ks[0], (BATCH, SEQ, D_MODEL), f32),
        "p": jax.random.normal(ks[1], (DEPTH, BATCH, SEQ, PLE_DIM), f32),
        "g_mix_pre": gain(ks[2]),
        "w_in": w(ks[3], (DEPTH, D_MODEL, W_IN_COLS), D_MODEL),
        "b_f": 2.0 + 0.5 * jax.random.normal(ks[4], (DEPTH, N_HEADS_FOX), f32),
        "w_br_a": w(ks[5], (DEPTH, N_HEADS_FOX * HEAD_DIM, D_MODEL), N_HEADS_FOX * HEAD_DIM),
        "w_br_b": w(ks[6], (DEPTH, HEADS_PER_DIL * HEAD_DIM, D_MODEL), HEADS_PER_DIL * HEAD_DIM),
        "w_br_c": w(ks[7], (DEPTH, N_HEADS_MOBA * HEAD_DIM, D_MODEL), N_HEADS_MOBA * HEAD_DIM),
        "w_out": w(ks[8], (DEPTH, D_MODEL, D_MODEL), D_MODEL),
        "g_mix_post": gain(ks[9]),
        "g_ffn_pre": gain(ks[10]),
        "w_ffn_gate": w(ks[11], (DEPTH, D_MODEL, D_FF), D_MODEL),
        "w_ffn_up": w(ks[12], (DEPTH, D_MODEL, D_FF), D_MODEL),
        "w_ffn_down": w(ks[13], (DEPTH, D_FF, D_MODEL), D_FF),
        "g_ffn_post": gain(ks[14]),
        "w_ple": w(ks[15], (DEPTH, PLE_DIM, D_MODEL), PLE_DIM),
        "w_ple_gate": w(ks[16], (DEPTH, D_MODEL, D_MODEL), D_MODEL),
        "g_ple_post": gain(ks[17]),
    }


def reference(x, p, g_mix_pre, w_in, b_f, w_br_a, w_br_b, w_br_c, w_out, g_mix_post,
              g_ffn_pre, w_ffn_gate, w_ffn_up, w_ffn_down, g_ffn_post, w_ple, w_ple_gate, g_ple_post):
    B, S, _ = x.shape
    cos, sin = rope_tables(S)
    cos = cos.astype(jnp.float32)
    sin = sin.astype(jnp.float32)
    for i in range(DEPTH):
        h = rms_norm(x, g_mix_pre[i])
        proj = jnp.einsum('bsd,dc->bsc', h, w_in[i])
        q = proj[..., :MIX_WIDTH].reshape(B, S, N_HEADS, HEAD_DIM)
        k = proj[..., MIX_WIDTH:2 * MIX_WIDTH].reshape(B, S, N_HEADS, HEAD_DIM)
        v = proj[..., 2 * MIX_WIDTH:3 * MIX_WIDTH].reshape(B, S, N_HEADS, HEAD_DIM)
        f_logit = proj[..., 3 * MIX_WIDTH:3 * MIX_WIDTH + N_HEADS_FOX] + b_f[i]
        gates = jax.nn.sigmoid(proj[..., 3 * MIX_WIDTH + N_HEADS_FOX:])
        g_a = gates[..., :D_MODEL]
        g_b = gates[..., D_MODEL:2 * D_MODEL]
        g_c = gates[..., 2 * D_MODEL:]
        q_r = apply_rope(q[:, :, N_HEADS_FOX:], cos, sin)
        k_r = apply_rope(k[:, :, N_HEADS_FOX:], cos, sin)
        y_a = fox_attention(q[:, :, :N_HEADS_FOX], k[:, :, :N_HEADS_FOX], v[:, :, :N_HEADS_FOX], f_logit)
        y_b = dilated_attention(q_r[:, :, :N_HEADS_DIL], k_r[:, :, :N_HEADS_DIL],
                                v[:, :, N_HEADS_FOX:N_HEADS_FOX + N_HEADS_DIL])
        y_c = moba_attention(q_r[:, :, N_HEADS_DIL:], k_r[:, :, N_HEADS_DIL:],
                             v[:, :, N_HEADS_FOX + N_HEADS_DIL:])
        merged = (g_a * jnp.einsum('bsc,cd->bsd', y_a, w_br_a[i])
                  + g_b * jnp.einsum('bsc,cd->bsd', y_b, w_br_b[i])
                  + g_c * jnp.einsum('bsc,cd->bsd', y_c, w_br_c[i]))
        x = x + rms_norm(jnp.einsum('bsd,de->bse', merged, w_out[i]), g_mix_post[i])
        h = rms_norm(x, g_ffn_pre[i])
        ff = jax.nn.silu(jnp.einsum('bsd,df->bsf', h, w_ffn_gate[i])) * jnp.einsum('bsd,df->bsf', h, w_ffn_up[i])
        x = x + rms_norm(jnp.einsum('bsf,fd->bsd', ff, w_ffn_down[i]), g_ffn_post[i])
        ple = jnp.einsum('bse,ed->bsd', p[i], w_ple[i]) * jax.nn.sigmoid(jnp.einsum('bsd,de->bse', x, w_ple_gate[i]))
        x = x + rms_norm(ple, g_ple_post[i])
    return x
```

```cpp
#include <hip/hip_runtime.h>
#include <cstdio>
#include <cstdint>

constexpr int BATCH = 4, SEQ = 8192, DM = 1024, DEPTH = 2, M = BATCH * SEQ;
constexpr int DFF = 2816, WINC = 6148, PLED = 256;
constexpr float RMS_EPS = 1e-6f;
constexpr float LOG2E = 1.4426950408889634f;
constexpr float C2 = 0.125f * 1.4426950408889634f;
constexpr int NWAVES = 8;
constexpr int YP = 1024;

namespace pg8 {
#define PG8_LAS __attribute__((address_space(3)))
typedef unsigned short bf16_t;
typedef short bf16x8 __attribute__((ext_vector_type(8)));
typedef float f32x4 __attribute__((ext_vector_type(4)));
typedef float f32x2 __attribute__((ext_vector_type(2)));
typedef unsigned u32x4 __attribute__((ext_vector_type(4)));
typedef unsigned u32x2 __attribute__((ext_vector_type(2)));
typedef int i32x4 __attribute__((ext_vector_type(4)));
typedef int i32x8 __attribute__((ext_vector_type(8)));
constexpr int BM = 256, BK = 64, HALF = 128, HTB = HALF * BK * 2, STAGE_BYTES = 8 * HTB, NXCD = 8, WGM = 4;

__host__ __device__ __forceinline__ int lds_byte(int r, int c) { const int st = (r >> 4) * 2 + (c >> 5), rr = r & 15, cc = c & 31, ob = rr * 64 + cc * 2; return st * 1024 + (ob ^ (((ob >> 9) & 1) << 5)); }
__host__ __device__ __forceinline__ void stage_rc(int b, int& R, int& C) { const int st = b / 1024, sb = b % 1024, swz = sb ^ (((sb >> 9) & 1) << 5); R = (st >> 1) * 16 + swz / 64; C = (st & 1) * 32 + (swz % 64) / 2; }

struct UnitG { int pm, pn, sub, ti; };

template <int NSUB, int LDA, int LDB, int NN, int K0A, int K0B, int K0C, int NTA, int NTB, int NTC, int SUBROW = 0, bool FP8 = false> struct Prob {
    static constexpr int lda = LDA, ldb = LDB, nM = 128, nN = NN; static constexpr bool fp8 = FP8;
    const bf16_t* A; const bf16_t* Bt; int G, c;
    __device__ __forceinline__ bool next(int i, UnitG& u) const {
        constexpr int nwg = nM * nN; const long L = (long)(i / NSUB) * G + c; if (L >= nwg) return false;
        int wgid = (int)L; { constexpr int q = nwg / NXCD, r = nwg % NXCD; const int xcd = wgid % NXCD, off = wgid / NXCD; wgid = (xcd < r ? xcd * (q + 1) : r * (q + 1) + (xcd - r) * q) + off; }
        constexpr int nig = WGM * nN; const int gid = wgid / nig, fm = gid * WGM;
        u.pm = fm + ((wgid % nig) % WGM); u.pn = (wgid % nig) / WGM; u.sub = i % NSUB; u.ti = i / NSUB; return true;
    }
    __device__ __forceinline__ void addr(const UnitG& u, const char*& a, const char*& b, int& nt) const {
        const int k0 = u.sub == 0 ? K0A : (u.sub == 1 ? K0B : K0C); nt = u.sub == 0 ? NTA : (u.sub == 1 ? NTB : NTC);
        a = (const char*)(A + (size_t)u.pm * BM * lda + k0); b = (const char*)(Bt + (size_t)(u.pn * BM + u.sub * SUBROW) * ldb + k0);
    }
};

__device__ __forceinline__ unsigned cvt_pk_bf16(float lo, float hi) { unsigned r; asm volatile("v_cvt_pk_bf16_f32 %0, %1, %2" : "=v"(r) : "v"(lo), "v"(hi)); return r; }
__device__ __forceinline__ float bf_lo(unsigned w) { return __uint_as_float(w << 16); }
__device__ __forceinline__ float bf_hi(unsigned w) { return __uint_as_float(w & 0xffff0000u); }
__device__ __forceinline__ float sigmoidf_(float x) { return __builtin_amdgcn_rcpf(1.0f + __builtin_amdgcn_exp2f(-x * LOG2E)); }


struct EpiPlain {
    bf16_t* O; int ldc;
    __device__ __forceinline__ bool operator()(f32x4 (&acc)[2][2][4][2], const UnitG& u, int wr, int wc, int fr, int fq) const {
        const int row0 = u.pm * BM + wr * 64 + fr, col0 = u.pn * BM + wc * 32 + 8 * fq;
#pragma unroll
        for (int ai = 0; ai < 2; ++ai)
#pragma unroll
            for (int m = 0; m < 4; ++m) { bf16_t* rowp = O + (size_t)(row0 + ai * HALF + m * 16) * ldc + col0;
#pragma unroll
                for (int bj = 0; bj < 2; ++bj) { const f32x4 v0 = acc[ai][bj][m][0], v1 = acc[ai][bj][m][1];
                    u32x4 w; w.x = cvt_pk_bf16(v0[0], v0[1]); w.y = cvt_pk_bf16(v0[2], v0[3]); w.z = cvt_pk_bf16(v1[0], v1[1]); w.w = cvt_pk_bf16(v1[2], v1[3]);
                    *(u32x4*)(rowp + bj * HALF) = w; } }
        return false;
    }
};
struct EpiGateS {
    bf16_t* S; float ascale;
    __device__ __forceinline__ bool operator()(f32x4 (&acc)[2][2][4][2], const UnitG& u, int wr, int wc, int fr, int fq) const {
        const int sub = u.sub; int tid = threadIdx.x; asm volatile("" : "+v"(tid));
        bf16_t* Sc = S + (size_t)(3 * u.ti + sub) * 65536 + tid * 8; bf16_t* Sp = Sc - (sub > 0 ? 65536 : 0);
#pragma unroll
        for (int hh = 0; hh < 2; ++hh) {
        u32x4 prev[8];
        if (sub > 0) {
#pragma unroll
            for (int g8 = 0; g8 < 8; ++g8) prev[g8] = *(const u32x4*)(Sp + (size_t)(hh * 8 + g8) * 4096);
        }
#pragma unroll
        for (int g8 = 0; g8 < 8; ++g8) { const int g = hh * 8 + g8, ai = g >> 3, m = (g >> 1) & 3, bj = g & 1;
            f32x4 v0 = acc[ai][bj][m][0], v1 = acc[ai][bj][m][1];
#pragma unroll
            for (int j = 0; j < 4; ++j) { v0[j] = fmaxf(sigmoidf_(v0[j] * ascale), 1e-30f); v1[j] = fmaxf(sigmoidf_(v1[j] * ascale), 1e-30f); }
            u32x4 w; w.x = cvt_pk_bf16(v0[0], v0[1]); w.y = cvt_pk_bf16(v0[2], v0[3]); w.z = cvt_pk_bf16(v1[0], v1[1]); w.w = cvt_pk_bf16(v1[2], v1[3]);
            *(u32x4*)(Sc + (size_t)g * 4096) = w;
            if (sub > 0) { const u32x4 p = prev[g8]; const float pv[8] = {bf_lo(p.x), bf_hi(p.x), bf_lo(p.y), bf_hi(p.y), bf_lo(p.z), bf_hi(p.z), bf_lo(p.w), bf_hi(p.w)};
                float r[8];
#pragma unroll
                for (int j = 0; j < 4; ++j) { r[j] = pv[j] * __builtin_amdgcn_rcpf(v0[j]); r[4 + j] = pv[4 + j] * __builtin_amdgcn_rcpf(v1[j]); }
                u32x4 q; q.x = cvt_pk_bf16(r[0], r[1]); q.y = cvt_pk_bf16(r[2], r[3]); q.z = cvt_pk_bf16(r[4], r[5]); q.w = cvt_pk_bf16(r[6], r[7]);
                *(u32x4*)(Sp + (size_t)g * 4096) = q; } }
        asm volatile("" ::: "memory"); }
        return false;
    }
};
struct EpiSwiGLU {
    bf16_t* O; int ldc; float isc;
    __device__ __forceinline__ bool operator()(f32x4 (&acc)[2][2][4][2], const UnitG& u, int wr, int wc, int fr, int fq) const {
        const int row0 = u.pm * BM + wr * 64 + fr, col0 = u.pn * HALF + wc * 32 + 8 * fq;
#pragma unroll
        for (int ai = 0; ai < 2; ++ai)
#pragma unroll
            for (int m = 0; m < 4; ++m) { bf16_t* rowp = O + (size_t)(row0 + ai * HALF + m * 16) * ldc + col0;
                f32x4 v0, v1;
#pragma unroll
                for (int j = 0; j < 4; ++j) { const float g0 = acc[ai][0][m][0][j] * isc, g1 = acc[ai][0][m][1][j] * isc;
                    v0[j] = g0 * sigmoidf_(g0) * (acc[ai][1][m][0][j] * isc); v1[j] = g1 * sigmoidf_(g1) * (acc[ai][1][m][1][j] * isc); }
                u32x4 w; w.x = cvt_pk_bf16(v0[0], v0[1]); w.y = cvt_pk_bf16(v0[2], v0[3]); w.z = cvt_pk_bf16(v1[0], v1[1]); w.w = cvt_pk_bf16(v1[2], v1[3]);
                *(u32x4*)rowp = w; }
        return false;
    }
};
struct EpiSwiGLU8 {
    unsigned char* O; int ldc; float isc;
    __device__ __forceinline__ bool operator()(f32x4 (&acc)[2][2][4][2], const UnitG& u, int wr, int wc, int fr, int fq) const {
        const int row0 = u.pm * BM + wr * 64 + fr, col0 = u.pn * HALF + wc * 32 + 8 * fq;
#pragma unroll
        for (int ai = 0; ai < 2; ++ai)
#pragma unroll
            for (int m = 0; m < 4; ++m) { unsigned char* rowp = O + (size_t)(row0 + ai * HALF + m * 16) * ldc + col0;
                f32x4 v0, v1;
#pragma unroll
                for (int j = 0; j < 4; ++j) { const float g0 = acc[ai][0][m][0][j] * isc, g1 = acc[ai][0][m][1][j] * isc;
                    v0[j] = g0 * sigmoidf_(g0) * (acc[ai][1][m][0][j] * isc) * 4.0f; v1[j] = g1 * sigmoidf_(g1) * (acc[ai][1][m][1][j] * isc) * 4.0f; }
                unsigned w0 = 0u, w1 = 0u;
                w0 = __builtin_amdgcn_cvt_pk_fp8_f32(v0[0], v0[1], w0, false); w0 = __builtin_amdgcn_cvt_pk_fp8_f32(v0[2], v0[3], w0, true);
                w1 = __builtin_amdgcn_cvt_pk_fp8_f32(v1[0], v1[1], w1, false); w1 = __builtin_amdgcn_cvt_pk_fp8_f32(v1[2], v1[3], w1, true);
                u32x2 w; w.x = w0; w.y = w1; *(u32x2*)rowp = w; }
        return false;
    }
};
struct EpiScaled {
    bf16_t* O; int ldc; float sc;
    __device__ __forceinline__ bool operator()(f32x4 (&acc)[2][2][4][2], const UnitG& u, int wr, int wc, int fr, int fq) const {
        const int row0 = u.pm * BM + wr * 64 + fr, col0 = u.pn * BM + wc * 32 + 8 * fq;
#pragma unroll
        for (int ai = 0; ai < 2; ++ai)
#pragma unroll
            for (int m = 0; m < 4; ++m) { bf16_t* rowp = O + (size_t)(row0 + ai * HALF + m * 16) * ldc + col0;
#pragma unroll
                for (int bj = 0; bj < 2; ++bj) { const f32x4 v0 = acc[ai][bj][m][0] * sc, v1 = acc[ai][bj][m][1] * sc;
                    u32x4 w; w.x = cvt_pk_bf16(v0[0], v0[1]); w.y = cvt_pk_bf16(v0[2], v0[3]); w.z = cvt_pk_bf16(v1[0], v1[1]); w.w = cvt_pk_bf16(v1[2], v1[3]);
                    *(u32x4*)(rowp + bj * HALF) = w; } }
        return false;
    }
};
struct EpiQKV {
    bf16_t *Q, *K, *V; const float* cs; float* kmp; unsigned* stat;
    __device__ __forceinline__ bool operator()(f32x4 (&acc)[2][2][4][2], const UnitG& u, int wr, int wc, int fr, int fq) const {
        const int sec = u.pn >> 2, pt = u.pn & 3;
        const int row0 = u.pm * BM + wr * 64 + fr;
        if (sec == 2) {
            const int col0 = pt * BM + wc * 32 + 8 * fq;
#pragma unroll
            for (int ai = 0; ai < 2; ++ai)
#pragma unroll
                for (int m = 0; m < 4; ++m) { bf16_t* rowp = V + (size_t)(row0 + ai * HALF + m * 16) * DM + col0;
#pragma unroll
                    for (int bj = 0; bj < 2; ++bj) { const f32x4 v0 = acc[ai][bj][m][0], v1 = acc[ai][bj][m][1];
                        u32x4 w; w.x = cvt_pk_bf16(v0[0], v0[1]); w.y = cvt_pk_bf16(v0[2], v0[3]); w.z = cvt_pk_bf16(v1[0], v1[1]); w.w = cvt_pk_bf16(v1[2], v1[3]);
                        *(u32x4*)(rowp + bj * HALF) = w; } }
        } else {
            bf16_t* dst = sec == 0 ? Q : K; const float sc = sec == 0 ? C2 : 1.0f; const bool rope = pt >= 1;
            const int dlo = 16 * (wc & 1) + 4 * fq;
            f32x4 ks[2][2]; float nmx[2] = {0.f, 0.f};
#pragma unroll
            for (int a = 0; a < 2; ++a)
#pragma unroll
                for (int b = 0; b < 2; ++b) ks[a][b] = (f32x4){0.f, 0.f, 0.f, 0.f};
            const float* csb = cs + (size_t)(row0 & (SEQ - 1)) * 32 + dlo;
            f32x4 cb = (f32x4){1.f, 1.f, 1.f, 1.f}, sb = (f32x4){0.f, 0.f, 0.f, 0.f}, c16 = cb, s16 = sb, c128 = cb, s128 = sb;
            if (rope) { cb = *(const f32x4*)csb; sb = *(const f32x4*)(csb + (size_t)SEQ * 32); c16 = *(const f32x4*)(cs + 16 * 32 + dlo); s16 = *(const f32x4*)(cs + (size_t)SEQ * 32 + 16 * 32 + dlo);
                c128 = *(const f32x4*)(cs + 128 * 32 + dlo); s128 = *(const f32x4*)(cs + (size_t)SEQ * 32 + 128 * 32 + dlo); }
            f32x4 c = cb, s = sb;
#pragma unroll
            for (int it = 0; it < 8; ++it) { const int ai = it >> 2, m = it & 3; const int row = row0 + ai * HALF + m * 16;
                if (it == 4) { c = cb * c128 - sb * s128; s = sb * c128 + cb * s128; }
                else if (it > 0) { const f32x4 cn = c * c16 - s * s16; s = s * c16 + c * s16; c = cn; }
#pragma unroll
                for (int bj = 0; bj < 2; ++bj) { const int head = 4 * pt + 2 * bj + (wc >> 1);
                    const f32x4 x1 = acc[ai][bj][m][0], x2 = acc[ai][bj][m][1];
                    const f32x4 o1 = (x1 * c - x2 * s) * sc, o2 = (x2 * c + x1 * s) * sc;
                    if (sec == 1 && pt >= 2) { ks[bj][0] += o1; ks[bj][1] += o2; }
                    if (pt == 0) { float ps = (o1[0] * o1[0] + o1[1] * o1[1]) + (o1[2] * o1[2] + o1[3] * o1[3]) + (o2[0] * o2[0] + o2[1] * o2[1]) + (o2[2] * o2[2] + o2[3] * o2[3]);
                        ps += __shfl_xor(ps, 16); ps += __shfl_xor(ps, 32); nmx[bj] = fmaxf(nmx[bj], ps); }
                    bf16_t* p = dst + (size_t)row * DM + head * 64 + dlo;
                    u32x2 w1, w2; w1.x = cvt_pk_bf16(o1[0], o1[1]); w1.y = cvt_pk_bf16(o1[2], o1[3]); w2.x = cvt_pk_bf16(o2[0], o2[1]); w2.y = cvt_pk_bf16(o2[2], o2[3]);
                    *(u32x2*)p = w1; *(u32x2*)(p + 32) = w2; }
                asm volatile("" : "+v"(ks[0][0]), "+v"(ks[0][1]), "+v"(ks[1][0]), "+v"(ks[1][1]) :: "memory"); }
            if (pt == 0) {
#pragma unroll
                for (int bj = 0; bj < 2; ++bj) { float x = nmx[bj]; x = fmaxf(x, __shfl_xor(x, 1)); x = fmaxf(x, __shfl_xor(x, 2)); x = fmaxf(x, __shfl_xor(x, 4)); x = fmaxf(x, __shfl_xor(x, 8));
                    if ((threadIdx.x & 63) == 0) __hip_atomic_fetch_max(stat + (((u.pm >> 5) * 2 + sec) * 4 + 2 * bj + (wc >> 1)) * 2 + (wc & 1), __float_as_uint(x), __ATOMIC_RELAXED, __HIP_MEMORY_SCOPE_AGENT); }
            }
            if (sec == 1 && pt >= 2) {
#pragma unroll
                for (int bj = 0; bj < 2; ++bj)
#pragma unroll
                    for (int n = 0; n < 2; ++n) { f32x4 v = ks[bj][n];
#pragma unroll
                        for (int j = 0; j < 4; ++j) { float x = v[j]; x += __shfl_xor(x, 1); x += __shfl_xor(x, 2); x += __shfl_xor(x, 4); x += __shfl_xor(x, 8); v[j] = x; }
                        if (fr == 0) { const int head = 4 * pt + 2 * bj + (wc >> 1); *(f32x4*)(kmp + ((size_t)u.pm * 2 + wr) * DM + head * 64 + dlo + 32 * n) = v; } }
            }
        }
        return false;
    }
};
struct EpiMergeS {
    const bf16_t* S; bf16_t* O;
    __device__ __forceinline__ bool operator()(f32x4 (&acc)[2][2][4][2], const UnitG& u, int wr, int wc, int fr, int fq) const {
        const int row0 = u.pm * BM + wr * 64 + fr, col0 = u.pn * BM + wc * 32 + 8 * fq; const int sub = u.sub; int tid = threadIdx.x; asm volatile("" : "+v"(tid));
        const bf16_t* Sc = S + (size_t)(3 * u.ti + sub) * 65536 + tid * 8;
        u32x4 gv[16];
#pragma unroll
        for (int g = 0; g < 16; ++g) gv[g] = *(const u32x4*)(Sc + (size_t)g * 4096);
#pragma unroll
        for (int g = 0; g < 16; ++g) { const int ai = g >> 3, m = (g >> 1) & 3, bj = g & 1; const u32x4 g1 = gv[g];
            const float r[8] = {bf_lo(g1.x), bf_hi(g1.x), bf_lo(g1.y), bf_hi(g1.y), bf_lo(g1.z), bf_hi(g1.z), bf_lo(g1.w), bf_hi(g1.w)};
            f32x4 v0 = acc[ai][bj][m][0], v1 = acc[ai][bj][m][1];
#pragma unroll
            for (int j = 0; j < 4; ++j) { v0[j] *= r[j]; v1[j] *= r[4 + j]; }
            acc[ai][bj][m][0] = v0; acc[ai][bj][m][1] = v1;
            if (sub == 2) { u32x4 w; w.x = cvt_pk_bf16(v0[0], v0[1]); w.y = cvt_pk_bf16(v0[2], v0[3]); w.z = cvt_pk_bf16(v1[0], v1[1]); w.w = cvt_pk_bf16(v1[2], v1[3]);
                *(u32x4*)(O + (size_t)(row0 + ai * HALF + m * 16) * DM + col0 + bj * HALF) = w; } }
        return sub < 2;
    }
};
struct EpiPLE {
    bf16_t* T; bf16_t* O;
    __device__ __forceinline__ bool operator()(f32x4 (&acc)[2][2][4][2], const UnitG& u, int wr, int wc, int fr, int fq) const {
        const int row0 = u.pm * BM + wr * 64 + fr, col0 = u.pn * BM + wc * 32 + 8 * fq; int tid = threadIdx.x; asm volatile("" : "+v"(tid));
        if (u.sub == 0) {
#pragma unroll
            for (int g = 0; g < 16; ++g) { const int ai = g >> 3, m = (g >> 1) & 3, bj = g & 1; const f32x4 v0 = acc[ai][bj][m][0], v1 = acc[ai][bj][m][1];
                int tt = tid; asm volatile("" : "+v"(tt));
                u32x4 w; w.x = cvt_pk_bf16(v0[0], v0[1]); w.y = cvt_pk_bf16(v0[2], v0[3]); w.z = cvt_pk_bf16(v1[0], v1[1]); w.w = cvt_pk_bf16(v1[2], v1[3]); *(u32x4*)(T + (size_t)g * 4096 + tt * 8) = w; }
        } else {
#pragma unroll
            for (int hh = 0; hh < 2; ++hh) {
                u32x4 tv8[8]; int tt = tid, r0 = row0; asm volatile("" : "+v"(tt), "+v"(r0));
#pragma unroll
                for (int g8 = 0; g8 < 8; ++g8) tv8[g8] = *(const u32x4*)(T + (size_t)(hh * 8 + g8) * 4096 + tt * 8);
#pragma unroll
                for (int g8 = 0; g8 < 8; ++g8) { const int g = hh * 8 + g8, ai = g >> 3, m = (g >> 1) & 3, bj = g & 1; const u32x4 t = tv8[g8];
                    const float tv[8] = {bf_lo(t.x), bf_hi(t.x), bf_lo(t.y), bf_hi(t.y), bf_lo(t.z), bf_hi(t.z), bf_lo(t.w), bf_hi(t.w)};
                    f32x4 v0 = acc[ai][bj][m][0], v1 = acc[ai][bj][m][1];
#pragma unroll
                    for (int j = 0; j < 4; ++j) { v0[j] = tv[j] * sigmoidf_(v0[j]); v1[j] = tv[4 + j] * sigmoidf_(v1[j]); }
                    u32x4 w; w.x = cvt_pk_bf16(v0[0], v0[1]); w.y = cvt_pk_bf16(v0[2], v0[3]); w.z = cvt_pk_bf16(v1[0], v1[1]); w.w = cvt_pk_bf16(v1[2], v1[3]);
                    *(u32x4*)(O + (size_t)(r0 + ai * HALF + m * 16) * DM + col0 + bj * HALF) = w; }
                asm volatile("" ::: "memory"); }
        }
        return false;
    }
};

template <class Epi, class ProbT>
__device__ __forceinline__ void gemm_phase(PG8_LAS unsigned char* lds, const ProbT& P, const Epi& E) {
    int tid_ = threadIdx.x; asm volatile("" : "+v"(tid_));
    const int tid = tid_, wid = __builtin_amdgcn_readfirstlane(tid >> 6), lane = tid & 63, wr = wid >> 2, wc = wid & 3, fr = lane & 15, fq = lane >> 4;
    unsigned voffA[2], voffB[2];
#pragma unroll
    for (int i = 0; i < 2; ++i) { int R, C; stage_rc(tid * 16 + i * 8192, R, C); voffA[i] = (unsigned)(R * ProbT::lda + C) * 2u; voffB[i] = (unsigned)(R * ProbT::ldb + C) * 2u; }
    if constexpr (ProbT::fp8) { *(PG8_LAS u32x4*)(lds + STAGE_BYTES + 2048 + tid * 16) = (u32x4){voffA[0], voffA[1], voffB[0], voffB[1]}; asm volatile("s_waitcnt lgkmcnt(0)" ::: "memory"); }
    constexpr size_t kstep = (size_t)(BK * 2);
    constexpr size_t hstepA = (size_t)HALF * ProbT::lda * 2, hstepB = (size_t)HALF * ProbT::ldb * 2;
    const unsigned ldsw = (unsigned)wid * 1024u;
    const int aoff = lds_byte(wr * 64 + fr, fq * 8), boff = lds_byte(wc * 32 + fr, fq * 8);
    PG8_LAS unsigned char* ldsA = lds + aoff; PG8_LAS unsigned char* ldsB = lds + 4 * HTB + boff;
#define PG8_SA(b, h) (((b) * 2 + (h)) * HTB)
#define PG8_SB(b, h) ((4 + (b) * 2 + (h)) * HTB)
#define PG8_STAGE(bufoff, gbase, voff) do { unsigned vo_[2]; if constexpr (ProbT::fp8) { const u32x4 q_ = *(const PG8_LAS u32x4*)(lds + STAGE_BYTES + 2048 + tid * 16); vo_[0] = (&(voff)[0] == &voffA[0]) ? q_.x : q_.z; vo_[1] = (&(voff)[0] == &voffA[0]) ? q_.y : q_.w; } \
        else { vo_[0] = (voff)[0]; vo_[1] = (voff)[1]; } \
        _Pragma("unroll") for (int _i = 0; _i < 2; ++_i) \
        __builtin_amdgcn_global_load_lds((const unsigned*)((const char*)(gbase) + vo_[_i]), (PG8_LAS unsigned*)(lds + (bufoff) + ldsw + _i * 8192), 16, 0, 0); } while (0)
#define PG8_RD16A(off) (*(const PG8_LAS i32x4*)(ldsA + (off)))
#define PG8_LDA(dst, b, h) do { if constexpr (ProbT::fp8) { _Pragma("unroll") for (int m = 0; m < 4; ++m) dst##8[m] = __builtin_shufflevector(PG8_RD16A(PG8_SA(b, h) + m * 2048), PG8_RD16A(PG8_SA(b, h) + m * 2048 + 1024), 0, 1, 2, 3, 4, 5, 6, 7); } \
        else { _Pragma("unroll") for (int m = 0; m < 4; ++m) _Pragma("unroll") for (int k = 0; k < 2; ++k) dst[m][k] = *(const PG8_LAS bf16x8*)(ldsA + PG8_SA(b, h) + m * 2048 + k * 1024); } } while (0)
#define PG8_SBR(b, h) (((b) * 2 + (h)) * HTB)
#define PG8_RD16B(off) (*(const PG8_LAS i32x4*)(ldsB + (off)))
#define PG8_LDB(dst, b, h) do { if constexpr (ProbT::fp8) { _Pragma("unroll") for (int n = 0; n < 2; ++n) dst##8[n] = __builtin_shufflevector(PG8_RD16B(PG8_SBR(b, h) + n * 2048), PG8_RD16B(PG8_SBR(b, h) + n * 2048 + 1024), 0, 1, 2, 3, 4, 5, 6, 7); } \
        else { _Pragma("unroll") for (int n = 0; n < 2; ++n) _Pragma("unroll") for (int k = 0; k < 2; ++k) dst[n][k] = *(const PG8_LAS bf16x8*)(ldsB + PG8_SBR(b, h) + n * 2048 + k * 1024); } } while (0)
#define PG8_MMA(ai, bj, At, Bt) do { __builtin_amdgcn_s_setprio(1); \
        if constexpr (ProbT::fp8) { _Pragma("unroll") for (int m = 0; m < 4; ++m) _Pragma("unroll") for (int n = 0; n < 2; ++n) \
            acc[ai][bj][m][n] = __builtin_amdgcn_mfma_scale_f32_16x16x128_f8f6f4(Bt##8[n], At##8[m], acc[ai][bj][m][n], 0, 0, 0, 0x7f7f7f7f, 0, 0x7f7f7f7f); } \
        else { _Pragma("unroll") for (int m = 0; m < 4; ++m) _Pragma("unroll") for (int n = 0; n < 2; ++n) _Pragma("unroll") for (int k = 0; k < 2; ++k) \
            acc[ai][bj][m][n] = __builtin_amdgcn_mfma_f32_16x16x32_bf16(Bt[n][k], At[m][k], acc[ai][bj][m][n], 0, 0, 0); } \
        __builtin_amdgcn_s_setprio(0); } while (0)
#define PG8_WAIT_V(n) asm volatile("s_waitcnt vmcnt(" #n ")" ::: "memory")
#define PG8_WAIT_L(n) asm volatile("s_waitcnt lgkmcnt(" #n ")" ::: "memory")
#define PG8_BAR __builtin_amdgcn_s_barrier()
#define PG8_SCHED __builtin_amdgcn_sched_barrier(0)
    UnitG cur, nxt; int ui = 0;
    if (!P.next(0, cur)) return;
    f32x4 acc[2][2][4][2];
#pragma unroll
    for (int a = 0; a < 2; ++a)
#pragma unroll
        for (int b = 0; b < 2; ++b)
#pragma unroll
            for (int m = 0; m < 4; ++m)
#pragma unroll
                for (int n = 0; n < 2; ++n) acc[a][b][m][n] = (f32x4){0.f, 0.f, 0.f, 0.f};
    bf16x8 At[4][2], B0[2][2], B1[2][2]; i32x8 At8[4], B08[2], B18[2];
    const char* cA; const char* cB; int nt; P.addr(cur, cA, cB, nt);
    PG8_STAGE(PG8_SB(0, 0), cB, voffB); PG8_STAGE(PG8_SB(0, 1), cB + hstepB, voffB); PG8_STAGE(PG8_SA(0, 0), cA, voffA); PG8_STAGE(PG8_SA(0, 1), cA + hstepA, voffA);
    if (wr == 1) PG8_BAR;
    PG8_WAIT_V(2); PG8_BAR;
    PG8_STAGE(PG8_SB(1, 0), cB + kstep, voffB); PG8_STAGE(PG8_SA(1, 0), cA + kstep, voffA); PG8_STAGE(PG8_SB(1, 1), cB + hstepB + kstep, voffB);
    PG8_WAIT_V(6); PG8_BAR;
    for (;;) {
        const bool has_next = P.next(ui + 1, nxt);
        const char* nA = cA; const char* nB = cB; int nnt = nt;
        if (has_next) P.addr(nxt, nA, nB, nnt);
#pragma clang loop unroll(disable)
        for (int t = 0; t < nt; t += 2) {
            const bool last = (t == nt - 2);
            const char* a1 = cA + (size_t)(t + 1) * kstep;
            const char* a2 = last ? nA : cA + (size_t)(t + 2) * kstep; const char* b2 = last ? nB : cB + (size_t)(t + 2) * kstep;
            const char* a3 = a2 + kstep; const char* b3 = b2 + kstep;
            PG8_LDB(B0, 0, 0); PG8_LDB(B1, 0, 1); PG8_SCHED; PG8_LDA(At, 0, 0); PG8_STAGE(PG8_SA(1, 1), a1 + hstepA, voffA);
            PG8_WAIT_V(8); PG8_WAIT_L(0); PG8_BAR; PG8_MMA(0, 0, At, B0); PG8_MMA(0, 1, At, B1); PG8_BAR; PG8_SCHED;
            PG8_LDA(At, 0, 1); PG8_STAGE(PG8_SB(0, 0), b2, voffB); PG8_STAGE(PG8_SB(0, 1), b2 + hstepB, voffB); PG8_STAGE(PG8_SA(0, 0), a2, voffA);
            PG8_WAIT_V(8); PG8_WAIT_L(0); PG8_BAR; PG8_MMA(1, 0, At, B0); PG8_MMA(1, 1, At, B1); PG8_BAR; PG8_SCHED;
            PG8_LDB(B0, 1, 0); PG8_LDB(B1, 1, 1); PG8_SCHED; PG8_LDA(At, 1, 0); PG8_STAGE(PG8_SA(0, 1), a2 + hstepA, voffA);
            PG8_WAIT_V(8); PG8_WAIT_L(0); PG8_BAR; PG8_MMA(0, 0, At, B0); PG8_MMA(0, 1, At, B1); PG8_BAR; PG8_SCHED;
            PG8_LDA(At, 1, 1); PG8_STAGE(PG8_SB(1, 0), b3, voffB); PG8_STAGE(PG8_SB(1, 1), b3 + hstepB, voffB); PG8_STAGE(PG8_SA(1, 0), a3, voffA);
            PG8_WAIT_V(8); PG8_WAIT_L(0); PG8_BAR; PG8_MMA(1, 0, At, B0); PG8_MMA(1, 1, At, B1); PG8_BAR; PG8_SCHED;
        }
        if (wr == 0) PG8_BAR;
        int t2_ = threadIdx.x; asm volatile("" : "+v"(t2_)); const int w2_ = __builtin_amdgcn_readfirstlane(t2_ >> 6);
        const bool keep = E(acc, cur, w2_ >> 2, w2_ & 3, t2_ & 15, (t2_ & 63) >> 4);
        if (!has_next) break;
        if (!keep) {
#pragma unroll
            for (int a = 0; a < 2; ++a)
#pragma unroll
                for (int b = 0; b < 2; ++b)
#pragma unroll
                    for (int m = 0; m < 4; ++m)
#pragma unroll
                        for (int n = 0; n < 2; ++n) acc[a][b][m][n] = (f32x4){0.f, 0.f, 0.f, 0.f};
        }
        cur = nxt; cA = nA; cB = nB; nt = nnt; ++ui;
        if (wr == 1) PG8_BAR;
    }
    PG8_WAIT_V(0);
    PG8_BAR;
#undef PG8_SA
#undef PG8_SB
#undef PG8_STAGE
#undef PG8_LDA
#undef PG8_LDB
#undef PG8_MMA
#undef PG8_RD16A
#undef PG8_RD16B
#undef PG8_SBR
#undef PG8_WAIT_V
#undef PG8_WAIT_L
#undef PG8_BAR
#undef PG8_SCHED
}
}

constexpr size_t MiB = 1u << 20;
constexpr size_t WS_CTL = 0, CTL_ZERO_BYTES = 128 * 1024;
constexpr size_t WS_TAB = 1 * MiB;
constexpr size_t WS_KMP = 3 * MiB;
constexpr size_t WS_LS = 4 * MiB;
constexpr size_t WS_BIASC = 4 * MiB + 512 * 1024;
constexpr size_t WS_BIASK = 6 * MiB;
constexpr size_t WS_W = 8 * MiB, W_LAYER_BYTES = 35 * MiB;
constexpr size_t OW_IN = 0, OW_BR = 6291456, OW_OUT = 7340032, OW_GU = 8388608, OW_DN = 14155776, OW_PP = 17039360, OW_END = 18350080;
static_assert(OW_END * 2 <= W_LAYER_BYTES, "weights");
constexpr size_t WS_XN = 80 * MiB;
constexpr size_t WS_Q = 144 * MiB, WS_K = 208 * MiB, WS_V = 272 * MiB;
constexpr size_t WS_GATES = 144 * MiB;
constexpr size_t WS_Y3 = 144 * MiB;
constexpr size_t WS_FF = 208 * MiB;
constexpr size_t WS_Y = 336 * MiB;
constexpr size_t WS_XBP = 384 * MiB;
constexpr size_t WS_MERGED = 440 * MiB;
constexpr size_t WS_TSCR = 464 * MiB;
constexpr size_t WS_END = 504 * MiB;
constexpr int CW_BAR = 1024;

constexpr int RING_OFF = 0, RING_BYTES = 131072;
constexpr int LDSCTL_OFF = RING_BYTES + 12288, MISC_OFF = LDSCTL_OFF + 320;
constexpr int LDS_BYTES = 147456;

#define GAS __attribute__((address_space(1)))
#define LAS __attribute__((address_space(3)))
typedef unsigned short bf16;
typedef unsigned v4u __attribute__((ext_vector_type(4)));
typedef unsigned v2u __attribute__((ext_vector_type(2)));
typedef float f32x4 __attribute__((ext_vector_type(4)));
typedef GAS unsigned gu32;
#define LDS_WAIT() asm volatile("s_waitcnt lgkmcnt(0)" ::: "memory")
#define VM_WAIT() asm volatile("s_waitcnt vmcnt(0)" ::: "memory")
__device__ __forceinline__ unsigned f2bf(float f) { unsigned u = __builtin_bit_cast(unsigned, f); return (u + 0x7fffu + ((u >> 16) & 1u)) >> 16; }
__device__ __forceinline__ unsigned pk2(float lo, float hi) { return f2bf(lo) | (f2bf(hi) << 16); }
__device__ __forceinline__ float bflo(unsigned w) { return __uint_as_float(w << 16); }
__device__ __forceinline__ float bfhi(unsigned w) { return __uint_as_float(w & 0xffff0000u); }

#define XB_TMO      128
#define XB_XCNT(j)  (256  + 64 * (j))
#define XB_XSUB(j)  (1280 + 64 * (j))
#define XB_XGEN(j)  (2304 + 64 * (j))
#define XB_TOP      3328
#define XB_TOPGEN   3392
#define XCD_BAR_WORDS 3456
#define XB_SPIN_CAP (1u << 18)
__device__ __forceinline__ unsigned xb_ld(unsigned* p)              { return __hip_atomic_load(p, __ATOMIC_RELAXED, __HIP_MEMORY_SCOPE_AGENT); }
__device__ __forceinline__ unsigned xb_add(unsigned* p, unsigned v) { return __hip_atomic_fetch_add(p, v, __ATOMIC_RELAXED, __HIP_MEMORY_SCOPE_AGENT); }
__device__ __forceinline__ unsigned xb_xcc_id() { return (unsigned)__builtin_amdgcn_s_getreg((3 << 11) | 20) & 0xFu; }
#define XB_SPIN(cond, bar) do { unsigned _sp = 0; while (cond) { __builtin_amdgcn_s_sleep(1); \
    if ((++_sp & 255u) == 0u) { if (xb_ld(&(bar)[XB_TMO])) break; if (_sp > XB_SPIN_CAP) { atomicAdd(&(bar)[XB_TMO], 1u); break; } } } } while (0)
struct XcdBarrier { unsigned* bar; unsigned x; volatile LAS unsigned* st; };
__device__ __forceinline__ XcdBarrier xcd_barrier_post(unsigned* bar, volatile LAS unsigned* st) {
    XcdBarrier b; b.bar = bar; b.x = xb_xcc_id(); b.st = st;
    if (threadIdx.x == 0) (void)xb_add(&bar[XB_XCNT(b.x)], 1u);
    return b;
}
__device__ __forceinline__ void xcd_barrier_complete(unsigned* bar, unsigned x, unsigned& nloc, unsigned& nx) {
    const unsigned G = gridDim.x * gridDim.y * gridDim.z;
    unsigned sum, cnt, mine, sp = 0u;
    for (;;) {
        sum = 0u; cnt = 0u; mine = 0u;
#pragma unroll
        for (unsigned j = 0; j < 16; ++j) { const unsigned c = xb_ld(&bar[XB_XCNT(j)]); sum += c; cnt += (c > 0u) ? 1u : 0u; mine = (j == x) ? c : mine; }
        if (sum == G) break;
        __builtin_amdgcn_s_sleep(1);
        if ((++sp & 255u) == 0u) { if (xb_ld(&bar[XB_TMO])) break; if (sp > XB_SPIN_CAP) { atomicAdd(&bar[XB_TMO], 1u); break; } }
    }
    nloc = mine > 0u ? mine : 1u; nx = cnt > 0u ? cnt : 1u;
}
__device__ __forceinline__ void xcd_barrier(const XcdBarrier& b) {
    asm volatile("s_waitcnt vmcnt(0)" ::: "memory");
    __syncthreads();
    if (threadIdx.x == 0) {
        unsigned* bar = b.bar; asm volatile("" : "+s"(bar));
        __builtin_amdgcn_s_waitcnt(0);
        unsigned nloc = b.st[0], nx = b.st[1];
        unsigned bx = b.x; asm volatile("" : "+s"(bx));
        if (nloc == 0u) { xcd_barrier_complete(bar, bx, nloc, nx); b.st[0] = nloc; b.st[1] = nx; }
        const unsigned old = xb_add(&bar[XB_XSUB(bx)], 1u);
        const unsigned gen = old / nloc;
        if (old + 1u == (gen + 1u) * nloc) {
            __builtin_amdgcn_fence(__ATOMIC_RELEASE, "agent");
            asm volatile("s_waitcnt vmcnt(0)" ::: "memory");
            const unsigned og = xb_add(&bar[XB_TOP], 1u);
            const unsigned tg = og / nx;
            if (og + 1u == (tg + 1u) * nx) xb_add(&bar[XB_TOPGEN], 1u);
            else XB_SPIN(xb_ld(&bar[XB_TOPGEN]) == tg, bar);
            __builtin_amdgcn_fence(__ATOMIC_ACQUIRE, "agent");
            xb_add(&bar[XB_XGEN(bx)], 1u);
            asm volatile("s_waitcnt vmcnt(0)" ::: "memory");
        } else {
            XB_SPIN(xb_ld(&bar[XB_XGEN(bx)]) == gen, bar);
            __builtin_amdgcn_fence(__ATOMIC_ACQUIRE, "agent");
            asm volatile("s_waitcnt vmcnt(0)" ::: "memory");
        }
    }
    __syncthreads();
}

struct Args { const float* in[18]; float* out; unsigned char* ws; int ph_lo, ph_hi; };
struct Frame {
    LAS unsigned char* lds; int tid, lane, wave, G, bid;
};

__device__ __forceinline__ float wave_sum(float v) {
#pragma unroll
    for (int o = 1; o < 64; o <<= 1) v += __shfl_xor(v, o);
    return v;
}

enum { MAP_P8 = 0, MAP_ROPE = 1, MAP_GU0 = 2, MAP_GU1 = 3 };
__device__ __forceinline__ int p8inv(int c) { return 16 * ((c >> 2) & 1) + 4 * (c >> 3) + (c & 3); }
__device__ __forceinline__ int rowmap(int kind, int n) {
    if (kind == MAP_ROPE) { const int d = n & 63; return (n & ~63) + 32 * ((d >> 4) & 1) + 16 * (d >> 5) + (d & 15); }
    if (kind == MAP_P8) return (n & ~31) + p8inv(n & 31);
    return 256 * (n >> 7) + (kind == MAP_GU1 ? 128 : 0) + (n & 96) + p8inv(n & 31);
}
__device__ __forceinline__ void wconv_item(const float* W, int ldw, int col0, int N, bf16* WT, int ldt, int koff, int kind, int rowoff, LAS float* scr, int item, int lane) {
    const int nblk = N / 32, kb = item / nblk, nb = item % nblk, k0 = 64 * kb, n0 = 32 * nb;
#pragma unroll 8
    for (int i = 0; i < 32; ++i) { const int kk = 2 * i + (lane >> 5); scr[kk * 33 + (lane & 31)] = W[(size_t)(k0 + kk) * ldw + col0 + n0 + (lane & 31)]; }
    LDS_WAIT(); asm volatile("" ::: "memory");
    const int c = lane & 7;
#pragma unroll
    for (int j = 0; j < 4; ++j) { const int n = (lane >> 3) + 8 * j; const LAS float* s = scr + (8 * c) * 33 + n;
        v4u o; o.x = pk2(s[0 * 33], s[1 * 33]); o.y = pk2(s[2 * 33], s[3 * 33]); o.z = pk2(s[4 * 33], s[5 * 33]); o.w = pk2(s[6 * 33], s[7 * 33]);
        *(GAS v4u*)(WT + (size_t)(rowoff + rowmap(kind, n0 + n)) * ldt + koff + k0 + 8 * c) = o; }
    LDS_WAIT(); asm volatile("" ::: "memory");
}

__device__ __forceinline__ void wconv8_item(const float* W, int ldw, int col0, int N, unsigned char* WT8, LAS float* scr, int item, int lane, int ldt8 = 1024, float scale = 64.0f, int kind = MAP_P8) {
    const int nblk = N / 32, kb = item / nblk, nb = item % nblk, k0 = 64 * kb, n0 = 32 * nb;
#pragma unroll 8
    for (int i = 0; i < 32; ++i) { const int kk = 2 * i + (lane >> 5); scr[kk * 33 + (lane & 31)] = W[(size_t)(k0 + kk) * ldw + col0 + n0 + (lane & 31)] * scale; }
    LDS_WAIT(); asm volatile("" ::: "memory");
    const int c = lane & 7;
#pragma unroll
    for (int j = 0; j < 4; ++j) { const int n = (lane >> 3) + 8 * j; const LAS float* s = scr + (8 * c) * 33 + n;
        unsigned w0 = 0u, w1 = 0u;
        w0 = __builtin_amdgcn_cvt_pk_fp8_f32(s[0 * 33], s[1 * 33], w0, false); w0 = __builtin_amdgcn_cvt_pk_fp8_f32(s[2 * 33], s[3 * 33], w0, true);
        w1 = __builtin_amdgcn_cvt_pk_fp8_f32(s[4 * 33], s[5 * 33], w1, false); w1 = __builtin_amdgcn_cvt_pk_fp8_f32(s[6 * 33], s[7 * 33], w1, true);
        v2u o; o.x = w0; o.y = w1;
        *(GAS v2u*)(WT8 + (size_t)rowmap(kind, n0 + n) * ldt8 + k0 + 8 * c) = o; }
    LDS_WAIT(); asm volatile("" ::: "memory");
}

__device__ __forceinline__ float log_sigmoid(float f) { return fminf(f, 0.f) - __logf(1.f + __expf(-fabsf(f))); }

__device__ __forceinline__ void row_norm_out(const f32x4 (&v)[4], const f32x4 (&g)[4], bf16* xnrow, int lane, const LAS float* wf, const float* bf, float* lsrow, unsigned char* x8row = nullptr) {
    float ss = 0.f;
#pragma unroll
    for (int j = 0; j < 4; ++j) ss += (v[j].x * v[j].x + v[j].y * v[j].y) + (v[j].z * v[j].z + v[j].w * v[j].w);
    const float r = rsqrtf(wave_sum(ss) * (1.f / DM) + RMS_EPS);
    f32x4 h[4];
#pragma unroll
    for (int j = 0; j < 4; ++j) h[j] = v[j] * r * g[j];
    if (xnrow) { GAS v2u* o8 = (GAS v2u*)xnrow + lane;
#pragma unroll
        for (int j = 0; j < 4; ++j) { v2u w; w.x = pk2(h[j].x, h[j].y); w.y = pk2(h[j].z, h[j].w); o8[64 * j] = w; } }
    if (x8row) {
#pragma unroll
        for (int j = 0; j < 4; ++j) { unsigned w = 0u; w = __builtin_amdgcn_cvt_pk_fp8_f32(h[j].x, h[j].y, w, false); w = __builtin_amdgcn_cvt_pk_fp8_f32(h[j].z, h[j].w, w, true); *((GAS unsigned*)x8row + lane + 64 * j) = w; } }
    if (lsrow) {
        f32x4 f = (f32x4){0.f, 0.f, 0.f, 0.f};
#pragma unroll
        for (int j = 0; j < 4; ++j) { const LAS f32x4* wp = (const LAS f32x4*)wf + (4 * lane + 256 * j);
            f += wp[0] * h[j].x; f += wp[1] * h[j].y; f += wp[2] * h[j].z; f += wp[3] * h[j].w; }
        f.x = wave_sum(f.x); f.y = wave_sum(f.y); f.z = wave_sum(f.z); f.w = wave_sum(f.w);
        if (lane == 0) { f32x4 o; o.x = log_sigmoid(f.x + bf[0]); o.y = log_sigmoid(f.y + bf[1]); o.z = log_sigmoid(f.z + bf[2]); o.w = log_sigmoid(f.w + bf[3]); *(GAS f32x4*)lsrow = o; }
    }
}
__device__ __forceinline__ void load_wf(Frame& F, const float* w_in_l) {
    LAS f32x4* wf = (LAS f32x4*)(F.lds + RING_OFF);
    for (int k = F.tid; k < DM; k += NWAVES * 64) wf[k] = *(const GAS f32x4*)(w_in_l + (size_t)k * WINC + 3072);
    __syncthreads();
}
__device__ __forceinline__ void pass_t0(Frame& F, const float* x, const float* g_pre, const float* w_in_l, const float* bf, bf16* XN, float* LS, unsigned char* XN8) {
    load_wf(F, w_in_l);
    f32x4 g[4];
#pragma unroll
    for (int j = 0; j < 4; ++j) g[j] = *((const GAS f32x4*)g_pre + F.lane + 64 * j);
    const int gw = F.bid * NWAVES + F.wave, NGW = F.G * NWAVES;
    f32x4 va[4], vb[4];
    auto ld0 = [&](f32x4 (&v)[4], int m) {
#pragma unroll
        for (int j = 0; j < 4; ++j) v[j] = __builtin_nontemporal_load((const GAS f32x4*)(x + (size_t)m * DM) + F.lane + 64 * j); };
    if (gw < M) ld0(va, gw);
    if (gw + NGW < M) ld0(vb, gw + NGW);
    for (int m = gw; m < M; m += 2 * NGW) {
        { f32x4 v[4];
#pragma unroll
          for (int j = 0; j < 4; ++j) v[j] = va[j];
          if (m + 2 * NGW < M) ld0(va, m + 2 * NGW);
          row_norm_out(v, g, XN + (size_t)m * DM, F.lane, (const LAS float*)(F.lds + RING_OFF), bf, LS + (size_t)m * 4, XN8 + (size_t)m * DM); }
        if (m + NGW < M) { f32x4 v[4];
#pragma unroll
          for (int j = 0; j < 4; ++j) v[j] = vb[j];
          if (m + 3 * NGW < M) ld0(vb, m + 3 * NGW);
          row_norm_out(v, g, XN + (size_t)(m + NGW) * DM, F.lane, (const LAS float*)(F.lds + RING_OFF), bf, LS + (size_t)(m + NGW) * 4, XN8 + (size_t)(m + NGW) * DM); }
    }
    __syncthreads();
}
template <int MODE, bool XI_F32, bool XO_F32>
__device__ __forceinline__ void pass_res(Frame& F, const bf16* Y, const void* xi, int ldi, void* xo, int ldo, const float* g_post, const float* g_next, bf16* XN, int ldn,
                                         const float* w_in_l, const float* bf, float* LS, const float* prow, unsigned char* XN8 = nullptr) {
    const bool do_ls = (MODE == 1) && (LS != nullptr);
    if (do_ls) load_wf(F, w_in_l);
    f32x4 gp[4], gn[4];
#pragma unroll
    for (int j = 0; j < 4; ++j) { gp[j] = *((const GAS f32x4*)g_post + F.lane + 64 * j); if (MODE == 1) gn[j] = *((const GAS f32x4*)g_next + F.lane + 64 * j); else gn[j] = gp[j]; }
    const int gw = F.bid * NWAVES + F.wave, NGW = F.G * NWAVES;
    struct RowBuf { v2u yr[4]; f32x4 xr4[4]; v2u xr2[4]; f32x4 pr; };
    auto ld_row = [&](RowBuf& R, int m) {
#pragma unroll
        for (int j = 0; j < 4; ++j) { R.yr[j] = __builtin_nontemporal_load((const GAS v2u*)(Y + (size_t)m * DM) + F.lane + 64 * j);
            if (XI_F32) R.xr4[j] = __builtin_nontemporal_load((const GAS f32x4*)((const float*)xi + (size_t)m * ldi) + F.lane + 64 * j);
            else R.xr2[j] = __builtin_nontemporal_load((const GAS v2u*)((const bf16*)xi + (size_t)m * ldi) + F.lane + 64 * j); }
        if (MODE == 2) R.pr = *((const GAS f32x4*)(prow + (size_t)m * PLED) + F.lane); };
    auto do_row = [&](const RowBuf& R, int m) {
        f32x4 y[4], v[4];
#pragma unroll
        for (int j = 0; j < 4; ++j) { y[j] = (f32x4){bflo(R.yr[j].x), bfhi(R.yr[j].x), bflo(R.yr[j].y), bfhi(R.yr[j].y)};
            if (XI_F32) v[j] = R.xr4[j]; else v[j] = (f32x4){bflo(R.xr2[j].x), bfhi(R.xr2[j].x), bflo(R.xr2[j].y), bfhi(R.xr2[j].y)}; }
        float ss = 0.f;
#pragma unroll
        for (int j = 0; j < 4; ++j) ss += (y[j].x * y[j].x + y[j].y * y[j].y) + (y[j].z * y[j].z + y[j].w * y[j].w);
        const float r = rsqrtf(wave_sum(ss) * (1.f / DM) + RMS_EPS);
#pragma unroll
        for (int j = 0; j < 4; ++j) { v[j] = v[j] + y[j] * r * gp[j];
            if (XO_F32) __builtin_nontemporal_store(v[j], (GAS f32x4*)((float*)xo + (size_t)m * ldo) + F.lane + 64 * j);
            else { v2u w; w.x = pk2(v[j].x, v[j].y); w.y = pk2(v[j].z, v[j].w);
                if (MODE == 2) *((GAS v2u*)((bf16*)xo + (size_t)m * ldo) + F.lane + 64 * j) = w;
                else __builtin_nontemporal_store(w, (GAS v2u*)((bf16*)xo + (size_t)m * ldo) + F.lane + 64 * j); } }
        if (MODE == 1) row_norm_out(v, gn, XN ? XN + (size_t)m * ldn : nullptr, F.lane, (const LAS float*)(F.lds + RING_OFF), bf, do_ls ? LS + (size_t)m * 4 : nullptr, XN8 ? XN8 + (size_t)m * DM : nullptr);
        if (MODE == 2) { v2u w; w.x = pk2(R.pr.x, R.pr.y); w.y = pk2(R.pr.z, R.pr.w); *((GAS v2u*)((bf16*)xo + (size_t)m * ldo) + F.lane + 256) = w; } };
    RowBuf A, B;
    if (gw < M) ld_row(A, gw);
    if (gw + NGW < M) ld_row(B, gw + NGW);
    for (int m = gw; m < M; m += 2 * NGW) {
        do_row(A, m); if (m + 2 * NGW < M) ld_row(A, m + 2 * NGW);
        if (m + NGW < M) { do_row(B, m + NGW); if (m + 3 * NGW < M) ld_row(B, m + 3 * NGW); }
    }
    if (do_ls) __syncthreads();
}

__device__ __forceinline__ void scan_phase(Frame& F, const float* LS, float* BIASC, bf16* BIASK) {
    LAS float* wt = (LAS float*)(F.lds + RING_OFF);
    for (int s = F.bid; s < 16; s += F.G) {
        const int b = s >> 2, h = s & 3; const int t0 = F.tid * 16;
        float v[16]; float run = 0.f;
#pragma unroll
        for (int i = 0; i < 16; ++i) { run += LS[((size_t)b * SEQ + t0 + i) * 4 + h]; v[i] = run; }
        float inc = run;
#pragma unroll
        for (int o = 1; o < 64; o <<= 1) { const float n = __int_as_float(__builtin_amdgcn_ds_bpermute((F.lane - o) * 4, __float_as_int(inc))); if (F.lane >= o) inc += n; }
        if (F.lane == 63) wt[F.wave] = inc;
        __syncthreads();
        float base = inc - run;
        for (int w = 0; w < F.wave; ++w) base += wt[w];
#pragma unroll
        for (int i = 0; i < 16; ++i) { const float x = -(base + v[i]) * LOG2E; BIASC[((size_t)b * 4 + h) * SEQ + t0 + i] = x;
            const unsigned h1 = f2bf(x); const float r1 = x - __uint_as_float(h1 << 16); const unsigned h2 = f2bf(r1); const float r2 = r1 - __uint_as_float(h2 << 16); const unsigned h3 = f2bf(r2);
            v4u w; w.x = h1 | (h2 << 16); w.y = h3; w.z = 0u; w.w = 0u; *(GAS v4u*)(BIASK + (((size_t)b * 4 + h) * SEQ + t0 + i) * 8) = w; }
        __syncthreads();
    }
}

namespace attn_body {
using bf16x8=__attribute__((ext_vector_type(8)))short;
using s16x4=__attribute__((ext_vector_type(4)))short;
using f32x16=__attribute__((ext_vector_type(16)))float;
using u32x4=__attribute__((ext_vector_type(4)))unsigned;
typedef unsigned short bf16;
constexpr int D=64,DMQ=1024;
constexpr int NW=8,QBLK=32,QB=QBLK*NW,KVBLK=64;
__device__ __forceinline__ int crow(int r,int hi){return (r&3)+8*(r>>2)+4*hi;}
#define SBAR() __builtin_amdgcn_sched_barrier(0)
__device__ __forceinline__ void cmask(f32x16&p0,f32x16&p1,int jb,int qrel,int hi){
  const float NEG=-INFINITY; int kb=64*jb+4*hi;
  #pragma unroll
  for(int r=0;r<16;++r){int kv=kb+(r&3)+8*(r>>2); if(kv>qrel)p0[r]=NEG; if(kv+32>qrel)p1[r]=NEG;}
}
__device__ __forceinline__ void wmask(f32x16&p0,f32x16&p1,int kbrel,int qrel,int hi){
  const float NEG=-INFINITY; int qh=qrel-4*hi; asm volatile("":"+v"(qh));
  #pragma unroll
  for(int r=0;r<16;++r){const int kv=kbrel+(r&3)+8*(r>>2); if(kv>qh||kv+128<qh)p0[r]=NEG; if(kv+32>qh||kv+160<qh)p1[r]=NEG;}
}
constexpr int NSLOT=3, SLOTB=8192;
constexpr int LDS_K=0, LDS_V=NSLOT*SLOTB, LDS_WS=2*NSLOT*SLOTB, LDS_OST=LDS_WS+NW*64*4, LDS_BIAS=LDS_OST+NW*4096, LDS_TAB=LDS_BIAS+NSLOT*1024, LDS_BYTES=LDS_TAB+2048;
__device__ __forceinline__ void glds16(const void*gsrc,unsigned lds_dst){unsigned keep;
  asm volatile("s_mov_b32 %0, m0\n\ts_mov_b32 m0, %2\n\ts_nop 0\n\tglobal_load_lds_dwordx4 %1, off\n\ts_mov_b32 m0, %0":"=&s"(keep):"v"(gsrc),"s"(lds_dst):"memory");}
__device__ __forceinline__ void glds4(const void*gsrc,unsigned lds_dst){unsigned keep;
  asm volatile("s_mov_b32 %0, m0\n\ts_mov_b32 m0, %2\n\ts_nop 0\n\tglobal_load_lds_dword %1, off\n\ts_mov_b32 m0, %0":"=&s"(keep):"v"(gsrc),"s"(lds_dst):"memory");}
__device__ __forceinline__ float max3f(float a,float b,float c){float r;asm("v_max3_f32 %0, %1, %2, %3":"=v"(r):"v"(a),"v"(b),"v"(c));return r;}
__device__ __forceinline__ float max2f(float a,float b){float r;asm("v_max_f32_e32 %0, %1, %2":"=v"(r):"v"(a),"v"(b));return r;}
__device__ __forceinline__ float fadd_s(float a,float b){float r;asm("v_add_f32_e32 %0, %1, %2":"=v"(r):"v"(a),"v"(b));return r;}
__device__ __forceinline__ float fsub_s(float a,float b){float r;asm("v_sub_f32_e32 %0, %1, %2":"=v"(r):"v"(a),"v"(b));return r;}
typedef float f32x2_t __attribute__((ext_vector_type(2))); typedef __bf16 bf16x2_t __attribute__((ext_vector_type(2)));
__device__ __forceinline__ unsigned cvtpk_s(float lo,float hi){f32x2_t v={lo,hi};bf16x2_t b=__builtin_convertvector(v,bf16x2_t);return __builtin_bit_cast(unsigned,b);}
#define WAIT_BAR(N) asm volatile("s_waitcnt vmcnt(%0) lgkmcnt(0)\n\ts_barrier"::"n"(N):"memory")

__device__ __forceinline__ void qkt(f32x16&p0,f32x16&p1,const char*Kslot,const bf16x8*qr,const f32x16&c0,const f32x16&c1,int r32,int hi){
  const char*kb=Kslot+hi*1024+r32*16;
  #pragma unroll
  for(int d0=0;d0<4;++d0){
    const bf16x8 b0=*reinterpret_cast<const bf16x8*>(kb+d0*2048);
    const bf16x8 b1=*reinterpret_cast<const bf16x8*>(kb+d0*2048+512);
    if(d0==0){p0=__builtin_amdgcn_mfma_f32_32x32x16_bf16(b0,qr[0],c0,0,0,0);p1=__builtin_amdgcn_mfma_f32_32x32x16_bf16(b1,qr[0],c1,0,0,0);}
    else{p0=__builtin_amdgcn_mfma_f32_32x32x16_bf16(b0,qr[d0],p0,0,0,0);p1=__builtin_amdgcn_mfma_f32_32x32x16_bf16(b1,qr[d0],p1,0,0,0);}}
}
typedef __attribute__((address_space(3))) const char* lds_cptr;
typedef short v4i16_t __attribute__((ext_vector_type(4)));
typedef float f32x4_t __attribute__((ext_vector_type(4)));
__device__ __forceinline__ void kload8(bf16x8*kf,lds_cptr kp){
  kf[0]=*(const __attribute__((address_space(3))) bf16x8*)(kp);      kf[1]=*(const __attribute__((address_space(3))) bf16x8*)(kp+512);
  kf[2]=*(const __attribute__((address_space(3))) bf16x8*)(kp+2048); kf[3]=*(const __attribute__((address_space(3))) bf16x8*)(kp+2560);
  kf[4]=*(const __attribute__((address_space(3))) bf16x8*)(kp+4096); kf[5]=*(const __attribute__((address_space(3))) bf16x8*)(kp+4608);
  kf[6]=*(const __attribute__((address_space(3))) bf16x8*)(kp+6144); kf[7]=*(const __attribute__((address_space(3))) bf16x8*)(kp+6656);
}
__device__ __forceinline__ void kload2(bf16x8*kf,lds_cptr kp,int j){ kf[2*j]=*(const __attribute__((address_space(3))) bf16x8*)(kp+j*2048); kf[2*j+1]=*(const __attribute__((address_space(3))) bf16x8*)(kp+j*2048+512); }
__device__ __forceinline__ s16x4 vtr(lds_cptr p){ return __builtin_bit_cast(s16x4,__builtin_amdgcn_ds_read_tr16_b64_v4i16((__attribute__((address_space(3))) v4i16_t*)p)); }
__device__ __forceinline__ float rowmax(const f32x16&p0,const f32x16&p1){
  float a=max3f(p0[0],p0[1],p1[0]),b=max3f(p0[2],p0[3],p1[1]);a=max3f(a,p1[2],p1[3]);
  #pragma unroll
  for(int r=4;r<16;r+=4){a=max3f(a,p0[r],p0[r+1]);b=max3f(b,p0[r+2],p0[r+3]);a=max3f(a,p1[r],p1[r+1]);b=max3f(b,p1[r+2],p1[r+3]);}
  const float m=max2f(a,b);
  auto rr=__builtin_amdgcn_permlane32_swap(__float_as_uint(m),__float_as_uint(m),false,false);
  return max2f(__uint_as_float(rr[0]),__uint_as_float(rr[1]));
}
__device__ __forceinline__ void pv(f32x16*o,int vb,bf16x8 pa0,bf16x8 pa1,bf16x8 pa2,bf16x8 pa3){
  #pragma unroll
  for(int d0=0;d0<2;++d0){s16x4 lo[4],hi[4];
    #pragma unroll
    for(int ks=0;ks<4;++ks){
      asm volatile("ds_read_b64_tr_b16 %0,%1 offset:%c2":"=&v"(lo[ks]):"v"(vb),"i"(d0*4096+ks*1024):"memory");
      asm volatile("ds_read_b64_tr_b16 %0,%1 offset:%c2":"=&v"(hi[ks]):"v"(vb),"i"(d0*4096+ks*1024+512):"memory");}
    asm volatile("s_waitcnt lgkmcnt(0)":::"memory");SBAR();
    #define PK(k) (bf16x8){lo[k][0],lo[k][1],lo[k][2],lo[k][3],hi[k][0],hi[k][1],hi[k][2],hi[k][3]}
    o[d0]=__builtin_amdgcn_mfma_f32_32x32x16_bf16(pa0,PK(0),o[d0],0,0,0);
    o[d0]=__builtin_amdgcn_mfma_f32_32x32x16_bf16(pa1,PK(1),o[d0],0,0,0);
    o[d0]=__builtin_amdgcn_mfma_f32_32x32x16_bf16(pa2,PK(2),o[d0],0,0,0);
    o[d0]=__builtin_amdgcn_mfma_f32_32x32x16_bf16(pa3,PK(3),o[d0],0,0,0);
    #undef PK
  }
}
__device__ __forceinline__ void add_bias(f32x16&p0,f32x16&p1,const __attribute__((address_space(3))) float*bp,int hi){
  #pragma unroll
  for(int g=0;g<4;++g){ const f32x4_t b0=*(const __attribute__((address_space(3))) f32x4_t*)(bp+8*g+4*hi), b1=*(const __attribute__((address_space(3))) f32x4_t*)(bp+32+8*g+4*hi);
    #pragma unroll
    for(int j=0;j<4;++j){ p0[4*g+j]+=b0[j]; p1[4*g+j]+=b1[j]; } }
}

struct UnitP {
  const bf16*Qh; const bf16*Kh; const bf16*Vh;
  bf16*Oh; int opitch;
  int rs;
  int q0;
  int t0, NT;
  const bf16*bias;
  const float*kmp; int own;
  float*lse; int lsep;
  const unsigned short*list; int cnt, e0;
  unsigned*glcnt; unsigned short*glist;
  bf16*PO; float*PL; int rowbase6;
};

template<int MODE,int THRL> __device__ __forceinline__ void attn_unit(const UnitP&U,char*shm){
  int tid_=threadIdx.x; asm volatile("":"+v"(tid_));
  const int tid=tid_,lane=tid&63,r32=lane&31,hi=lane>>5; const int wid=__builtin_amdgcn_readfirstlane(tid>>6);
  const int q0=U.q0; const long rsp=(long)U.rs*DMQ;
  const bf16*Qw=U.Qh+(long)(q0+wid*QBLK)*rsp;
  const unsigned lds0=(unsigned)(uintptr_t)shm;
  float*wsf=(float*)(shm+LDS_WS)+wid*64;
  __attribute__((address_space(3))) int*tab=(__attribute__((address_space(3))) int*)(shm+LDS_TAB);
  int NT=U.NT; unsigned selmask=0xffffffffu; unsigned uall=0u;
  struct Cur { unsigned rem; int blk, sub; };
  auto cur_init=[&](Cur&c){ c.rem=uall; c.blk=U.own; c.sub=0; };
  auto cur_next=[&](Cur&c)->int{ const int row=c.blk*256+c.sub*64; if(++c.sub==4){ c.sub=0; if(c.rem){c.blk=__builtin_ctz(c.rem);c.rem&=c.rem-1u;} else c.blk=U.own; } return row; };
  Cur ck,cv,cs;
  const bf16*ksrc=U.Kh+(long)lane*rsp+wid*8;
  const bf16*vsrc=U.Vh+(long)(16*(wid&3)+(lane>>2))*rsp+(wid>>2)*32+(lane&3)*8;
  const bf16*bsrc=(MODE==0)?(U.bias+lane*8):nullptr;
  const unsigned kdst=lds0+LDS_K+wid*1024, vdst=lds0+LDS_V+wid*1024, bdst=lds0+LDS_BIAS;
  constexpr int NDK=(MODE==0)?2:1;
  #define DMA_K(t,slot) do{ int tr_; if constexpr(MODE==1) tr_=cur_next(ck); else if constexpr(MODE==0) tr_=(U.t0+NT-1-(t))*64; else tr_=(U.t0+(t))*64; glds16(ksrc+(long)tr_*rsp,(unsigned)__builtin_amdgcn_readfirstlane(kdst+(slot))); \
      if constexpr(MODE==0) glds16(bsrc+(long)tr_*8,(unsigned)__builtin_amdgcn_readfirstlane(bdst+((slot)>>3))); }while(0)
  #define DMA_V(t,slot) do{ int tr_; if constexpr(MODE==1) tr_=cur_next(cv); else if constexpr(MODE==0) tr_=(U.t0+NT-1-(t))*64; else tr_=(U.t0+(t))*64; glds16(vsrc+(long)tr_*rsp,(unsigned)__builtin_amdgcn_readfirstlane(vdst+(slot))); }while(0)
  const char*Kbase=shm+LDS_K; bf16x8 kf[8]; bf16x8 kb0,kb1;
  const lds_cptr shm3=(lds_cptr)shm; const lds_cptr kp0=shm3+LDS_K+hi*1024+r32*16; const lds_cptr vp0=shm3+LDS_V+((lane>>4)&1)*32+(lane&3)*8+(4*hi+((lane&15)>>2))*64;
  const lds_cptr bp0=shm3+LDS_BIAS+r32*16;
  u32x4 qaw; qaw.x=(hi==0)?0x3f803f80u:0u; qaw.y=(hi==0)?0x00003f80u:0u; qaw.z=0u; qaw.w=0u; const bf16x8 qaug=__builtin_bit_cast(bf16x8,qaw);
  if constexpr(MODE==1){ cur_init(ck); cur_init(cv); cur_init(cs); }
  DMA_K(0,0);DMA_V(0,0);DMA_K(1,SLOTB);
  bf16x8 qr[4];
  if constexpr(MODE==4){
    const int e=U.e0+wid*QBLK+r32; const bool valid=e<U.cnt; const unsigned ent=*(const __attribute__((address_space(1))) unsigned short*)(U.list+(valid?e:U.cnt-1));
    const int tq=(int)(ent&8191u), slot=(int)(ent>>13);
    if(hi==0)tab[128+wid*QBLK+r32]=valid?((U.rowbase6+tq*6)*3+slot):-1;
    const bf16*Qg=U.Qh+(long)tq*DMQ;
    #pragma unroll
    for(int d0=0;d0<4;++d0)qr[d0]=*(const __attribute__((address_space(1))) bf16x8*)(&Qg[d0*16+hi*8]);
  } else {
  #pragma unroll
  for(int d0=0;d0<4;++d0)qr[d0]=*(const __attribute__((address_space(1))) bf16x8*)(&Qw[(long)r32*rsp+d0*16+hi*8]);
  }
  if constexpr(MODE==1||MODE==6){
    f32x16 g=f32x16{};
    #pragma unroll
    for(int d0=0;d0<4;++d0){ const float*kp=U.kmp+(long)r32*2048+d0*16+hi*8;
      typedef const __attribute__((address_space(1))) f32x4_t* gp4; const f32x4_t a0=*(gp4)kp,a1=*(gp4)(kp+4),b0=*(gp4)(kp+1024),b1=*(gp4)(kp+1028);
      const f32x4_t s0=a0+b0,s1=a1+b1; u32x4 w; w.x=cvtpk_s(s0[0],s0[1]);w.y=cvtpk_s(s0[2],s0[3]);w.z=cvtpk_s(s1[0],s1[1]);w.w=cvtpk_s(s1[2],s1[3]);
      g=__builtin_amdgcn_mfma_f32_32x32x16_bf16(__builtin_bit_cast(bf16x8,w),qr[d0],g,0,0,0); }
    #pragma unroll
    for(int r=0;r<16;++r) if(crow(r,hi)>=U.own) g[r]=-INFINITY;
    unsigned bits=0u;
    #pragma unroll
    for(int k=0;k<3;++k){
      float m=g[0];
      #pragma unroll
      for(int r=1;r<16;++r)m=__builtin_fmaxf(m,g[r]);
      auto rr=__builtin_amdgcn_permlane32_swap(__float_as_uint(m),__float_as_uint(m),false,false);
      const float mo=(hi==0)?__uint_as_float(rr[1]):__uint_as_float(rr[0]);
      const float gm=__builtin_fmaxf(m,mo);
      const bool mine=(m==gm)&&(gm>-INFINITY)&&!(hi==1&&mo==gm);
      bool found=!mine;
      #pragma unroll
      for(int r=0;r<16;++r){ const bool hit=(!found)&&(g[r]==gm); if(hit){g[r]=-INFINITY;bits|=(1u<<crow(r,hi));} found=found||hit; }
    }
    { auto rr=__builtin_amdgcn_permlane32_swap(bits,bits,false,false); bits=rr[0]|rr[1]; }
    if constexpr(MODE==6){
      if(tid<64)tab[tid]=0;
      asm volatile("s_waitcnt lgkmcnt(0)\n\ts_barrier":::"memory");
      int n0=-1,n1=-1,n2=-1,k0=0,k1=0,k2=0;
      if(hi==0){ unsigned bb=bits;
        if(bb){n0=__builtin_ctz(bb);bb&=bb-1u;k0=__hip_atomic_fetch_add(&tab[n0],1,__ATOMIC_RELAXED,__HIP_MEMORY_SCOPE_WORKGROUP);}
        if(bb){n1=__builtin_ctz(bb);bb&=bb-1u;k1=__hip_atomic_fetch_add(&tab[n1],1,__ATOMIC_RELAXED,__HIP_MEMORY_SCOPE_WORKGROUP);}
        if(bb){n2=__builtin_ctz(bb);k2=__hip_atomic_fetch_add(&tab[n2],1,__ATOMIC_RELAXED,__HIP_MEMORY_SCOPE_WORKGROUP);} }
      asm volatile("s_waitcnt lgkmcnt(0)\n\ts_barrier":::"memory");
      if(tid<32){ const int c=tab[tid]; if(c>0)tab[32+tid]=(int)__hip_atomic_fetch_add(U.glcnt+tid,(unsigned)c,__ATOMIC_RELAXED,__HIP_MEMORY_SCOPE_AGENT); }
      asm volatile("s_waitcnt vmcnt(0) lgkmcnt(0)\n\ts_barrier":::"memory");
      if(hi==0){ const unsigned tq=(unsigned)(q0+wid*QBLK+r32); __attribute__((address_space(1))) unsigned short*L=(__attribute__((address_space(1))) unsigned short*)U.glist;
        if(n0>=0)L[(long)n0*8192+tab[32+n0]+k0]=(unsigned short)(tq);
        if(n1>=0)L[(long)n1*8192+tab[32+n1]+k1]=(unsigned short)(tq|(1u<<13));
        if(n2>=0)L[(long)n2*8192+tab[32+n2]+k2]=(unsigned short)(tq|(2u<<13)); }
    } else {
    selmask=bits|(1u<<U.own);
    unsigned un=bits;
    #pragma unroll
    for(int o=1;o<32;o<<=1)un|=(unsigned)__shfl_xor((int)un,o);
    if(lane==0)tab[64+wid]=(int)un;
    asm volatile("s_waitcnt lgkmcnt(0)\n\ts_barrier":::"memory");
    #pragma unroll
    for(int w=0;w<8;++w)uall|=(unsigned)tab[64+w];
    uall=(unsigned)__builtin_amdgcn_readfirstlane((int)uall);
    NT=4*__builtin_popcount(uall)+4;
    }
  }
  if constexpr(MODE==1){ ck.rem=uall; cv.rem=uall; cs.rem=uall; }
  float mhat=0.f,l_reg=0.f;f32x16 o[2];o[0]=f32x16{};o[1]=f32x16{};f32x16 negm=f32x16{};
  #define NEGSEL() do{ if constexpr(MODE==1){ const int blk_=cs.blk; (void)cur_next(cs); const float nm_=((selmask>>blk_)&1u)?-mhat:-1e30f; _Pragma("unroll") for(int r=0;r<16;++r)negm[r]=nm_; asm volatile("":"+v"(negm)); } }while(0)
  NEGSEL();
  asm volatile("":"+v"(negm));
  const int qrel=wid*QBLK+r32;
  #define CMASK(P0,P1,t) do{ if constexpr(MODE==4){} else if constexpr(MODE==2){ wmask(P0,P1,(U.t0+(t))*64-q0,qrel,hi); } else if constexpr(MODE==1){ if((t)<4)cmask(P0,P1,(t),qrel,hi); } else if constexpr(MODE==0){ if((t)<4)cmask(P0,P1,3-(t),qrel,hi); } else { int jb_=(t)-(NT-4); if(jb_>=0)cmask(P0,P1,jb_,qrel,hi); } }while(0)
  bool resc=false;
  #define START(P0,P1) do{ const float rm=rowmax(P0,P1); resc=false; \
    { const float dl=__builtin_fmaxf(rm,-1000.f); mhat=fadd_s(mhat,dl); \
      _Pragma("unroll") for(int r=0;r<16;++r){P0[r]=fsub_s(P0[r],dl);P1[r]=fsub_s(P1[r],dl);} \
      _Pragma("unroll") for(int r=0;r<16;++r)negm[r]=-mhat; asm volatile("":"+v"(negm)); } \
    _Pragma("unroll") for(int r=0;r<16;++r)P0[r]=__builtin_amdgcn_exp2f(P0[r]); }while(0)
  #define RESC() do{ if(resc){ asm volatile("s_waitcnt lgkmcnt(0)":::"memory"); \
      _Pragma("unroll") for(int d_=0;d_<2;++d_) _Pragma("unroll") for(int r=0;r<16;++r)o[d_][r]*=wsf[crow(r,hi)]; } }while(0)
  f32x16 pA0,pA1,pB0,pB1;
  int sl_prev=0,sl_cur=0,sl_next=SLOTB;
  #define ROT() do{sl_prev=sl_cur;sl_cur=sl_next;sl_next=(sl_next==(NSLOT-1)*SLOTB)?0:sl_next+SLOTB;}while(0)
  DMA_K(2,2*SLOTB);
  WAIT_BAR(2*NDK+1);
  if constexpr(MODE==0){ const bf16x8 b0=*(const __attribute__((address_space(3))) bf16x8*)(bp0), b1=*(const __attribute__((address_space(3))) bf16x8*)(bp0+512);
    pA0=__builtin_amdgcn_mfma_f32_32x32x16_bf16(b0,qaug,negm,0,0,0); pA1=__builtin_amdgcn_mfma_f32_32x32x16_bf16(b1,qaug,negm,0,0,0); qkt(pA0,pA1,Kbase,qr,pA0,pA1,r32,hi); }
  else qkt(pA0,pA1,Kbase,qr,negm,negm,r32,hi);
  asm volatile("s_nop 15\n\ts_nop 7":"+v"(pA0),"+v"(pA1));CMASK(pA0,pA1,0);
  START(pA0,pA1);
  NEGSEL();
  _Pragma("unroll") for(int r=0;r<16;++r)pA1[r]=__builtin_amdgcn_exp2f(pA1[r]);
  WAIT_BAR(0);
  DMA_K(3,0);DMA_V(1,SLOTB);
  ROT();
  kload8(kf,kp0+sl_cur);
  if constexpr(MODE==0){ kb0=*(const __attribute__((address_space(3))) bf16x8*)(bp0+(sl_cur>>3)); kb1=*(const __attribute__((address_space(3))) bf16x8*)(bp0+(sl_cur>>3)+512); }
  WAIT_BAR(NDK+1);
  s16x4 vlo[8],vhi[8]; u32x4 pw0,pw1,pw2,pw3;
  #define PKW(P,B) cvtpk_s(P[B],P[B+1])
  #define PAF(k) __builtin_bit_cast(bf16x8,pw##k)
  #define VFR(i) (bf16x8){vlo[i][0],vlo[i][1],vlo[i][2],vlo[i][3],vhi[i][0],vhi[i][1],vhi[i][2],vhi[i][3]}
  #define PIN(x) asm volatile("":"+v"(x))
  #define MX3(a,b,c) __builtin_fmaxf(__builtin_fmaxf((a),(b)),(c))
  #define GAPA(MF,A0,A1,A2,A3,W0,W1,PW) do{ MF; sacc+=A0; sacc+=A1; sacc+=A2; sacc+=A3; PIN(sacc); W0; W1; PIN(PW); SBAR(); }while(0)
  #define EX(v) __builtin_amdgcn_exp2f(v)
  #define GAPB(MF,X,B) do{ MF; X[B]=EX(X[B]); X[B+1]=EX(X[B+1]); X[B+2]=EX(X[B+2]); X[B+3]=EX(X[B+3]); PIN(X); SBAR(); }while(0)
  #define VRD(i) do{ vlo[i]=vtr(vp_+(((i)>>2)*4096+((i)&3)*1024)); vhi[i]=vtr(vp_+(((i)>>2)*4096+((i)&3)*1024+512)); }while(0)
  #define KRD(G,j) do{ if(G){ kload2(kf,kp0+sl_next,j); SBAR(); } }while(0)
  #define KRDB(G) do{ if constexpr(MODE==0){ if(G){ kb0=*(const __attribute__((address_space(3))) bf16x8*)(bp0+(sl_next>>3)); kb1=*(const __attribute__((address_space(3))) bf16x8*)(bp0+(sl_next>>3)+512); SBAR(); } } }while(0)
  #define QK0(C0,C1) do{ if constexpr(MODE==0){ C0=__builtin_amdgcn_mfma_f32_32x32x16_bf16(kb0,qaug,negm,0,0,0); C1=__builtin_amdgcn_mfma_f32_32x32x16_bf16(kb1,qaug,negm,0,0,0); SBAR(); } }while(0)
  #define CIN(C) ((MODE==0)?C:negm)
  #define STEP(C0,C1,P0,P1,t,GK,GV,GL) do{ SBAR(); \
    const lds_cptr vp_=vp0+sl_prev; \
    QK0(C0,C1); \
    VRD(0); SBAR(); float sacc=(P0[0]+P0[1]); \
    GAPA(C0=__builtin_amdgcn_mfma_f32_32x32x16_bf16(kf[0],qr[0],CIN(C0),0,0,0), P0[2],P0[3],P0[4],P0[5],     pw0[0]=PKW(P0,0), pw0[1]=PKW(P0,2), pw0); \
    VRD(4); SBAR(); GAPA(C1=__builtin_amdgcn_mfma_f32_32x32x16_bf16(kf[1],qr[0],CIN(C1),0,0,0), P0[6],P0[7],P0[8],P0[9],     pw0[2]=PKW(P0,4), pw0[3]=PKW(P0,6), pw0); \
    VRD(1); SBAR(); GAPA(C0=__builtin_amdgcn_mfma_f32_32x32x16_bf16(kf[2],qr[1],C0,0,0,0),   P0[10],P0[11],P0[12],P0[13], pw1[0]=PKW(P0,8), pw1[1]=PKW(P0,10), pw1); \
    VRD(5); SBAR(); GAPA(C1=__builtin_amdgcn_mfma_f32_32x32x16_bf16(kf[3],qr[1],C1,0,0,0),   P0[14],P0[15],P1[0],P1[1],   pw1[2]=PKW(P0,12),pw1[3]=PKW(P0,14), pw1); \
    VRD(2); SBAR(); GAPA(C0=__builtin_amdgcn_mfma_f32_32x32x16_bf16(kf[4],qr[2],C0,0,0,0),   P1[2],P1[3],P1[4],P1[5],     pw2[0]=PKW(P1,0), pw2[1]=PKW(P1,2), pw2); \
    VRD(6); SBAR(); GAPA(C1=__builtin_amdgcn_mfma_f32_32x32x16_bf16(kf[5],qr[2],C1,0,0,0),   P1[6],P1[7],P1[8],P1[9],     pw2[2]=PKW(P1,4), pw2[3]=PKW(P1,6), pw2); \
    VRD(3); SBAR(); GAPA(C0=__builtin_amdgcn_mfma_f32_32x32x16_bf16(kf[6],qr[3],C0,0,0,0),   P1[10],P1[11],P1[12],P1[13], pw3[0]=PKW(P1,8), pw3[1]=PKW(P1,10), pw3); \
    VRD(7); SBAR(); GAPA(C1=__builtin_amdgcn_mfma_f32_32x32x16_bf16(kf[7],qr[3],C1,0,0,0),   P1[14],P1[15],0.f,0.f,       pw3[2]=PKW(P1,12),pw3[3]=PKW(P1,14), pw3); \
    l_reg+=sacc; \
    if(GK){DMA_K((t)+3,sl_cur);} if(GV){DMA_V((t)+1,sl_next);} \
    CMASK(C0,C1,t); \
    { float a=MX3(C0[0],C0[1],C1[0]),b=MX3(C0[2],C0[3],C1[1]); a=MX3(a,C1[2],C1[3]); \
      _Pragma("unroll") for(int r=4;r<16;r+=4){a=MX3(a,C0[r],C0[r+1]);b=MX3(b,C0[r+2],C0[r+3]);a=MX3(a,C1[r],C1[r+1]);b=MX3(b,C1[r+2],C1[r+3]);} \
      float rm=__builtin_fmaxf(a,b); { auto rr=__builtin_amdgcn_permlane32_swap(__float_as_uint(rm),__float_as_uint(rm),false,false); rm=__builtin_fmaxf(__uint_as_float(rr[0]),__uint_as_float(rr[1])); } \
      resc=false; \
      if(__builtin_expect(__any(rm>(float)THRL),0)){ const float dl=__builtin_fmaxf(rm,0.f); mhat+=dl; \
        _Pragma("unroll") for(int r=0;r<16;++r){C0[r]-=dl;C1[r]-=dl;} \
        _Pragma("unroll") for(int r=0;r<16;++r)negm[r]=-mhat; asm volatile("":"+v"(negm)); \
        const float f=__builtin_amdgcn_exp2f(-dl); l_reg*=f; if(hi==0)wsf[r32]=f; resc=true; } } \
    SBAR(); \
    GAPB(o[0]=__builtin_amdgcn_mfma_f32_32x32x16_bf16(PAF(0),VFR(0),o[0],0,0,0), C0,0); \
    GAPB(o[1]=__builtin_amdgcn_mfma_f32_32x32x16_bf16(PAF(0),VFR(4),o[1],0,0,0), C0,4); \
    if(GL){NEGSEL(); SBAR();} \
    KRD(GL,0); GAPB(o[0]=__builtin_amdgcn_mfma_f32_32x32x16_bf16(PAF(1),VFR(1),o[0],0,0,0), C0,8); \
    KRD(GL,1); GAPB(o[1]=__builtin_amdgcn_mfma_f32_32x32x16_bf16(PAF(1),VFR(5),o[1],0,0,0), C0,12); \
    KRD(GL,2); GAPB(o[0]=__builtin_amdgcn_mfma_f32_32x32x16_bf16(PAF(2),VFR(2),o[0],0,0,0), C1,0); \
    KRD(GL,3); GAPB(o[1]=__builtin_amdgcn_mfma_f32_32x32x16_bf16(PAF(2),VFR(6),o[1],0,0,0), C1,4); \
    KRDB(GL); GAPB(o[0]=__builtin_amdgcn_mfma_f32_32x32x16_bf16(PAF(3),VFR(3),o[0],0,0,0), C1,8); \
    GAPB(o[1]=__builtin_amdgcn_mfma_f32_32x32x16_bf16(PAF(3),VFR(7),o[1],0,0,0), C1,12); \
    }while(0)
  int t=1;
  if constexpr(MODE!=2){
  #undef CMASK
  #define CMASK(P0,P1,t) do{ if constexpr(MODE==1){ if((t)<4)cmask(P0,P1,(t),qrel,hi); } else if constexpr(MODE==0){ if((t)<4)cmask(P0,P1,3-(t),qrel,hi); } }while(0)
  for(;t+5<NT;t+=2){
    STEP(pB0,pB1,pA0,pA1,t,true,true,true);     WAIT_BAR(NDK+1); RESC(); ROT();
    STEP(pA0,pA1,pB0,pB1,t+1,true,true,true);   WAIT_BAR(NDK+1); RESC(); ROT();
  }
  #undef CMASK
  #define CMASK(P0,P1,t) do{ if constexpr(MODE==4){} else if constexpr(MODE==2){ wmask(P0,P1,(U.t0+(t))*64-q0,qrel,hi); } else if constexpr(MODE==1){ if((t)<4)cmask(P0,P1,(t),qrel,hi); } else if constexpr(MODE==0){ if((t)<4)cmask(P0,P1,3-(t),qrel,hi); } else { int jb_=(t)-(NT-4); if(jb_>=0)cmask(P0,P1,jb_,qrel,hi); } }while(0)
  }
  #define ENDW(tt) do{ if((tt)+3<NT){WAIT_BAR(NDK+1);} else if((tt)+2<NT){WAIT_BAR(1);} else {WAIT_BAR(0);} }while(0)
  for(;t+1<NT;t+=2){
    STEP(pB0,pB1,pA0,pA1,t,(t+3<NT),(t+1<NT),(t+1<NT));       ENDW(t);   RESC(); ROT();
    STEP(pA0,pA1,pB0,pB1,t+1,(t+4<NT),(t+2<NT),(t+2<NT));     ENDW(t+1); RESC(); ROT();
  }
  STEP(pB0,pB1,pA0,pA1,NT-1,false,false,false); RESC();
  { float sacc=pB0[0]+pB0[1]; _Pragma("unroll") for(int r=2;r<16;++r)sacc+=pB0[r]; _Pragma("unroll") for(int r=0;r<16;++r)sacc+=pB1[r]; l_reg+=sacc;
    pw0=(u32x4){PKW(pB0,0),PKW(pB0,2),PKW(pB0,4),PKW(pB0,6)};pw1=(u32x4){PKW(pB0,8),PKW(pB0,10),PKW(pB0,12),PKW(pB0,14)};pw2=(u32x4){PKW(pB1,0),PKW(pB1,2),PKW(pB1,4),PKW(pB1,6)};pw3=(u32x4){PKW(pB1,8),PKW(pB1,10),PKW(pB1,12),PKW(pB1,14)};
    int t2_=threadIdx.x; asm volatile("":"+v"(t2_)); const int l2_=t2_&63,h2_=l2_>>5;
    const int vb0=(int)(lds0+LDS_V)+((l2_>>4)&1)*32+(l2_&3)*8+(4*h2_+((l2_&15)>>2))*64;
    SBAR(); pv(o,vb0+sl_cur,PAF(0),PAF(1),PAF(2),PAF(3)); }
  #undef PKW
  #undef PAF
  #undef VFR
  #undef PIN
  #undef MX3
  #undef GAPA
  #undef GAPB
  #undef EX
  #undef VRD
  #undef KRD
  #undef KRDB
  #undef QK0
  #undef CIN
  #undef STEP
  #undef ENDW
  { int t3_=threadIdx.x; asm volatile("":"+v"(t3_)); const int lane3=t3_&63,r3=lane3&31,h3=lane3>>5,qrel3=wid*QBLK+r3;
  {auto rr=__builtin_amdgcn_permlane32_swap(__float_as_uint(l_reg),__float_as_uint(l_reg),false,false);l_reg=__uint_as_float(rr[0])+__uint_as_float(rr[1]);}
  if(h3==0)wsf[32+r3]=l_reg;asm volatile("s_waitcnt lgkmcnt(0)":::"memory");
  if constexpr(MODE==2||MODE==5||MODE==6){ if(h3==0)*(__attribute__((address_space(1))) float*)(U.lse+(long)(q0+qrel3)*U.rs*U.lsep)=mhat+__builtin_amdgcn_logf(l_reg); }
  if constexpr(MODE==4){ const int d_=tab[128+wid*QBLK+r3]; if(h3==0&&d_>=0)*(__attribute__((address_space(1))) float*)(U.PL+(long)(d_/3)*4+(d_%3))=mhat+__builtin_amdgcn_logf(l_reg); }
  float rli[16];
  #pragma unroll
  for(int r=0;r<16;++r)rli[r]=__builtin_amdgcn_rcpf(wsf[32+crow(r,h3)]);
  bf16*Ow=U.Oh+(long)(q0+wid*QBLK)*U.rs*U.opitch;
  { bf16*stg=(bf16*)(shm+LDS_OST)+wid*2048;
    #pragma unroll
    for(int r=0;r<16;++r){const int orow=crow(r,h3);
      #pragma unroll
      for(int d0=0;d0<2;++d0)stg[orow*64+d0*32+r3]=(bf16)(cvtpk_s(o[d0][r]*rli[r],0.f)&0xffffu);}
    asm volatile("s_waitcnt lgkmcnt(0)":::"memory");
    #pragma unroll
    for(int i=0;i<4;++i){const int row=i*8+(lane3>>3),ch=lane3&7; const u32x4 v=*(const u32x4*)(stg+row*64+ch*8);
      if constexpr(MODE==4){ const int d_=tab[128+wid*QBLK+row]; if(d_>=0)*(__attribute__((address_space(1))) u32x4*)(U.PO+(long)d_*64+ch*8)=v; }
      else *(__attribute__((address_space(1))) u32x4*)(Ow+(long)row*U.rs*U.opitch+ch*8)=v;} } }
  asm volatile("s_waitcnt lgkmcnt(0)\n\ts_barrier":::"memory");
  #undef DMA_K
  #undef DMA_V
  #undef CMASK
  #undef NEGSEL
  #undef START
  #undef RESC
  #undef ROT
}
constexpr int RS_K=0, RS_V=4*SLOTB, RS_WS=8*SLOTB, RS_OST=RS_WS+NW*256, RS_BYTES=RS_OST+NW*4096;
template<int THRL> __device__ __forceinline__ void routed_stat_unit(const bf16*Qh,const bf16*Kh,const bf16*Vh,const unsigned short*list,int e0,int e1,int n,bf16*PO,float*PL,int rowbase6,char*shm){
  int tid_=threadIdx.x; asm volatile("":"+v"(tid_));
  const int tid=tid_,lane=tid&63,r32=lane&31,hi=lane>>5; const int wid=__builtin_amdgcn_readfirstlane(tid>>6);
  const unsigned lds0=(unsigned)(uintptr_t)shm;
  { const bf16*ksrc=Kh+(long)(n*256+lane)*DMQ+wid*8; const bf16*vsrc=Vh+(long)(n*256+16*(wid&3)+(lane>>2))*DMQ+(wid>>2)*32+(lane&3)*8;
    #pragma unroll
    for(int t=0;t<4;++t){ glds16(ksrc+(long)t*64*DMQ,(unsigned)__builtin_amdgcn_readfirstlane(lds0+RS_K+t*SLOTB+wid*1024)); glds16(vsrc+(long)t*64*DMQ,(unsigned)__builtin_amdgcn_readfirstlane(lds0+RS_V+t*SLOTB+wid*1024)); }
    asm volatile("s_waitcnt vmcnt(0)\n\ts_barrier":::"memory"); }
  float*wsf=(float*)(shm+RS_WS)+wid*64;
  const lds_cptr vp0s=(lds_cptr)shm+RS_V+((lane>>4)&1)*32+(lane&3)*8+(4*hi+((lane&15)>>2))*64;
  const int ng=(e1-e0+31)>>5;
  typedef const __attribute__((address_space(1))) unsigned short* gu16p; typedef const __attribute__((address_space(1))) bf16x8* gq8p;
  int g=wid; unsigned ent=0u; bf16x8 qr[4];
  if(g<ng){ const int e=e0+g*32+r32; ent=*(gu16p)(list+(e<e1?e:e1-1));
    const bf16*Qg=Qh+(long)(ent&8191u)*DMQ;
    #pragma unroll
    for(int d0=0;d0<4;++d0)qr[d0]=*(gq8p)(Qg+d0*16+hi*8); }
  for(;g<ng;g+=NW){
    const int e=e0+g*32+r32; const bool valid=e<e1; const int dst=valid?((rowbase6+(int)(ent&8191u)*6)*3+(int)(ent>>13)):-1;
    const int gn=g+NW; unsigned entn=0u; if(gn<ng){ const int en=e0+gn*32+r32; entn=*(gu16p)(list+(en<e1?en:e1-1)); }
    bf16x8 qn[4];
    float mhat=0.f,l_reg=0.f; f32x16 o[2]; o[0]=f32x16{}; o[1]=f32x16{}; f32x16 negm=f32x16{};
    f32x16 pc0,pc1,pn0,pn1; qkt(pc0,pc1,shm+RS_K,qr,negm,negm,r32,hi);
    #pragma unroll
    for(int t=0;t<4;++t){
      if(t<3) qkt(pn0,pn1,shm+RS_K+(t+1)*SLOTB,qr,negm,negm,r32,hi);
      f32x16&p0=pc0; f32x16&p1=pc1;
      float a=__builtin_fmaxf(__builtin_fmaxf(p0[0],p0[1]),p1[0]),b=__builtin_fmaxf(__builtin_fmaxf(p0[2],p0[3]),p1[1]); a=__builtin_fmaxf(__builtin_fmaxf(a,p1[2]),p1[3]);
      #pragma unroll
      for(int r=4;r<16;r+=4){a=__builtin_fmaxf(__builtin_fmaxf(a,p0[r]),p0[r+1]);b=__builtin_fmaxf(__builtin_fmaxf(b,p0[r+2]),p0[r+3]);a=__builtin_fmaxf(__builtin_fmaxf(a,p1[r]),p1[r+1]);b=__builtin_fmaxf(__builtin_fmaxf(b,p1[r+2]),p1[r+3]);}
      float rm=__builtin_fmaxf(a,b); { auto rr=__builtin_amdgcn_permlane32_swap(__float_as_uint(rm),__float_as_uint(rm),false,false); rm=__builtin_fmaxf(__uint_as_float(rr[0]),__uint_as_float(rr[1])); }
      if(t==0){ const float dl=rm; mhat=dl;
        #pragma unroll
        for(int r=0;r<16;++r){p0[r]-=dl;p1[r]-=dl;pn0[r]-=dl;pn1[r]-=dl;}
        #pragma unroll
        for(int r=0;r<16;++r)negm[r]=-mhat; }
      else if(__builtin_expect(__any(rm>(float)THRL),0)){ const float dl=__builtin_fmaxf(rm,0.f); mhat+=dl;
        #pragma unroll
        for(int r=0;r<16;++r){p0[r]-=dl;p1[r]-=dl;}
        if(t<3){
          #pragma unroll
          for(int r=0;r<16;++r){pn0[r]-=dl;pn1[r]-=dl;} }
        #pragma unroll
        for(int r=0;r<16;++r)negm[r]=-mhat;
        const float f=__builtin_amdgcn_exp2f(-dl); l_reg*=f; if(hi==0)wsf[r32]=f;
        #pragma unroll
        for(int d_=0;d_<2;++d_)
          #pragma unroll
          for(int r=0;r<16;++r)o[d_][r]*=wsf[crow(r,hi)]; }
      s16x4 vlo[8],vhi[8]; { const lds_cptr vp_=vp0s+t*SLOTB;
        #pragma unroll
        for(int i=0;i<8;++i){ vlo[i]=vtr(vp_+((i>>2)*4096+(i&3)*1024)); vhi[i]=vtr(vp_+((i>>2)*4096+(i&3)*1024+512)); } }
      #pragma unroll
      for(int r=0;r<16;++r){p0[r]=__builtin_amdgcn_exp2f(p0[r]);p1[r]=__builtin_amdgcn_exp2f(p1[r]);}
      float sacc=0.f;
      #pragma unroll
      for(int r=0;r<16;++r)sacc+=p0[r]+p1[r];
      l_reg+=sacc;
      u32x4 pw0=(u32x4){cvtpk_s(p0[0],p0[1]),cvtpk_s(p0[2],p0[3]),cvtpk_s(p0[4],p0[5]),cvtpk_s(p0[6],p0[7])},pw1=(u32x4){cvtpk_s(p0[8],p0[9]),cvtpk_s(p0[10],p0[11]),cvtpk_s(p0[12],p0[13]),cvtpk_s(p0[14],p0[15])},
            pw2=(u32x4){cvtpk_s(p1[0],p1[1]),cvtpk_s(p1[2],p1[3]),cvtpk_s(p1[4],p1[5]),cvtpk_s(p1[6],p1[7])},pw3=(u32x4){cvtpk_s(p1[8],p1[9]),cvtpk_s(p1[10],p1[11]),cvtpk_s(p1[12],p1[13]),cvtpk_s(p1[14],p1[15])};
      #define VFRS(i) (bf16x8){vlo[i][0],vlo[i][1],vlo[i][2],vlo[i][3],vhi[i][0],vhi[i][1],vhi[i][2],vhi[i][3]}
      o[0]=__builtin_amdgcn_mfma_f32_32x32x16_bf16(__builtin_bit_cast(bf16x8,pw0),VFRS(0),o[0],0,0,0); o[1]=__builtin_amdgcn_mfma_f32_32x32x16_bf16(__builtin_bit_cast(bf16x8,pw0),VFRS(4),o[1],0,0,0);
      o[0]=__builtin_amdgcn_mfma_f32_32x32x16_bf16(__builtin_bit_cast(bf16x8,pw1),VFRS(1),o[0],0,0,0); o[1]=__builtin_amdgcn_mfma_f32_32x32x16_bf16(__builtin_bit_cast(bf16x8,pw1),VFRS(5),o[1],0,0,0);
      o[0]=__builtin_amdgcn_mfma_f32_32x32x16_bf16(__builtin_bit_cast(bf16x8,pw2),VFRS(2),o[0],0,0,0); o[1]=__builtin_amdgcn_mfma_f32_32x32x16_bf16(__builtin_bit_cast(bf16x8,pw2),VFRS(6),o[1],0,0,0);
      o[0]=__builtin_amdgcn_mfma_f32_32x32x16_bf16(__builtin_bit_cast(bf16x8,pw3),VFRS(3),o[0],0,0,0); o[1]=__builtin_amdgcn_mfma_f32_32x32x16_bf16(__builtin_bit_cast(bf16x8,pw3),VFRS(7),o[1],0,0,0);
      #undef VFRS
      if(t==1&&gn<ng){ const bf16*Qg=Qh+(long)(entn&8191u)*DMQ;
        #pragma unroll
        for(int d0=0;d0<4;++d0)qn[d0]=*(gq8p)(Qg+d0*16+hi*8); }
      if(t<3){ pc0=pn0; pc1=pn1; }
    }
    {auto rr=__builtin_amdgcn_permlane32_swap(__float_as_uint(l_reg),__float_as_uint(l_reg),false,false);l_reg=__uint_as_float(rr[0])+__uint_as_float(rr[1]);}
    if(hi==0){ wsf[32+r32]=l_reg; if(dst>=0)*(__attribute__((address_space(1))) float*)(PL+(long)(dst/3)*4+(dst%3))=mhat+__builtin_amdgcn_logf(l_reg); }
    float rli[16];
    #pragma unroll
    for(int r=0;r<16;++r)rli[r]=__builtin_amdgcn_rcpf(wsf[32+crow(r,hi)]);
    { bf16*stg=(bf16*)(shm+RS_OST)+wid*2048;
      #pragma unroll
      for(int r=0;r<16;++r){const int orow=crow(r,hi);
        #pragma unroll
        for(int d0=0;d0<2;++d0)stg[orow*64+d0*32+r32]=(bf16)(cvtpk_s(o[d0][r]*rli[r],0.f)&0xffffu);}
      #pragma unroll
      for(int i=0;i<4;++i){const int row=i*8+(lane>>3),ch=lane&7; const u32x4 v=*(const u32x4*)(stg+row*64+ch*8); const int dr=__shfl(dst,row);
        if(dr>=0)*(__attribute__((address_space(1))) u32x4*)(PO+(long)dr*64+ch*8)=v;} }
    if(gn<ng){
      #pragma unroll
      for(int d0=0;d0<4;++d0)qr[d0]=qn[d0]; }
    ent=entn;
  }
  asm volatile("s_waitcnt lgkmcnt(0)\n\ts_barrier":::"memory");
}
#undef SBAR
#undef WAIT_BAR
}

__device__ __forceinline__ void ld_row64(const bf16* p, float (&x)[64]) {
#pragma unroll
    for (int i = 0; i < 8; ++i) { const v4u w = *((const GAS v4u*)p + i);
        x[8 * i + 0] = bflo(w.x); x[8 * i + 1] = bfhi(w.x); x[8 * i + 2] = bflo(w.y); x[8 * i + 3] = bfhi(w.y);
        x[8 * i + 4] = bflo(w.z); x[8 * i + 5] = bfhi(w.z); x[8 * i + 6] = bflo(w.w); x[8 * i + 7] = bfhi(w.w); }
}
__device__ __forceinline__ float dot_row64(const bf16* kp, const float (&q)[64]) {
    float s0 = 0.f, s1 = 0.f;
#pragma unroll
    for (int i = 0; i < 8; ++i) { const v4u w = *((const GAS v4u*)kp + i);
        s0 += q[8 * i + 0] * bflo(w.x); s1 += q[8 * i + 1] * bfhi(w.x); s0 += q[8 * i + 2] * bflo(w.y); s1 += q[8 * i + 3] * bfhi(w.y);
        s0 += q[8 * i + 4] * bflo(w.z); s1 += q[8 * i + 5] * bfhi(w.z); s0 += q[8 * i + 6] * bflo(w.w); s1 += q[8 * i + 7] * bfhi(w.w); }
    return s0 + s1;
}
__device__ __forceinline__ void sm_update(float s, const bf16* vp, float& mx, float& l, float (&o)[64]) {
    const float mn = fmaxf(mx, s); const float a = __builtin_amdgcn_exp2f(mx - mn), p = __builtin_amdgcn_exp2f(s - mn);
    mx = mn; l = l * a + p;
#pragma unroll
    for (int i = 0; i < 8; ++i) { const v4u w = *((const GAS v4u*)vp + i);
        o[8 * i + 0] = o[8 * i + 0] * a + p * bflo(w.x); o[8 * i + 1] = o[8 * i + 1] * a + p * bfhi(w.x); o[8 * i + 2] = o[8 * i + 2] * a + p * bflo(w.y); o[8 * i + 3] = o[8 * i + 3] * a + p * bfhi(w.y);
        o[8 * i + 4] = o[8 * i + 4] * a + p * bflo(w.z); o[8 * i + 5] = o[8 * i + 5] * a + p * bfhi(w.z); o[8 * i + 6] = o[8 * i + 6] * a + p * bflo(w.w); o[8 * i + 7] = o[8 * i + 7] * a + p * bfhi(w.w); }
}
__device__ __forceinline__ void st_row64(bf16* p, const float (&o)[64], float inv) {
#pragma unroll
    for (int i = 0; i < 8; ++i) { v4u w; w.x = pk2(o[8 * i] * inv, o[8 * i + 1] * inv); w.y = pk2(o[8 * i + 2] * inv, o[8 * i + 3] * inv); w.z = pk2(o[8 * i + 4] * inv, o[8 * i + 5] * inv); w.w = pk2(o[8 * i + 6] * inv, o[8 * i + 7] * inv);
        *((GAS v4u*)p + i) = w; }
}
__device__ __forceinline__ void fox_simple(Frame& F, const bf16* Q, const bf16* K, const bf16* V, const float* BIASC, bf16* Y) {
    for (int task = F.bid * NWAVES + F.wave; task < 16 * 128; task += F.G * NWAVES) {
        const int bh = task >> 7, r = task & 127, j = r >> 3, w = r & 7; const int base = 32 * (w >> 1); const int tblk = (w & 1) ? base + 31 - j : base + j;
        const int b = bh >> 2, h = bh & 3; const int t = tblk * 64 + F.lane; const int tmax = tblk * 64 + 63;
        const size_t rb = (size_t)b * SEQ;
        float q[64], o[64]; ld_row64(Q + (rb + t) * DM + h * 64, q);
#pragma unroll
        for (int d = 0; d < 64; ++d) o[d] = 0.f;
        float mx = -INFINITY, l = 0.f;
        const float* bc = BIASC + ((size_t)b * 4 + h) * SEQ;
        for (int kk = 0; kk <= tmax; ++kk) {
            const bf16* kp = K + (rb + kk) * DM + h * 64; const bf16* vp = V + (rb + kk) * DM + h * 64;
            const float s = dot_row64(kp, q) + bc[kk];
            if (kk <= t) sm_update(s, vp, mx, l, o);
        }
        st_row64(Y + (rb + t) * YP + h * 64, o, 1.f / l);
    }
}
__device__ __forceinline__ void moba_simple(Frame& F, const bf16* Q, const bf16* K, const bf16* V, const float* KMP, bf16* Y) {
    const int gtid = F.bid * (NWAVES * 64) + F.tid, NT = F.G * NWAVES * 64;
    for (int g = gtid; g < BATCH * 6 * SEQ; g += NT) {
        const int bhm = g / SEQ, t = g % SEQ, b = bhm / 6, hm = bhm % 6, head = 10 + hm; const size_t rb = (size_t)b * SEQ;
        float q[64], o[64]; ld_row64(Q + (rb + t) * DM + head * 64, q);
#pragma unroll
        for (int d = 0; d < 64; ++d) o[d] = 0.f;
        const int own = t >> 8;
        float g0 = -INFINITY, g1 = -INFINITY, g2 = -INFINITY; int i0 = -1, i1 = -1, i2 = -1;
        for (int n = 0; n < own; ++n) {
            const float* k0 = KMP + ((size_t)(b * 32 + n) * 2) * DM + head * 64; const float* k1 = k0 + DM;
            float s = 0.f;
#pragma unroll
            for (int d = 0; d < 64; ++d) s += q[d] * (k0[d] + k1[d]);
            if (s > g0) { g2 = g1; i2 = i1; g1 = g0; i1 = i0; g0 = s; i0 = n; }
            else if (s > g1) { g2 = g1; i2 = i1; g1 = s; i1 = n; }
            else if (s > g2) { g2 = s; i2 = n; }
        }
        float mx = -INFINITY, l = 0.f;
        for (int c = 0; c < 4; ++c) {
            const int blk = c == 0 ? own : (c == 1 ? i0 : (c == 2 ? i1 : i2));
            if (blk < 0) continue;
            const int kend = (c == 0) ? (t & 255) : 255;
            for (int kk = 0; kk <= kend; ++kk) {
                const size_t row = rb + blk * 256 + kk;
                const float s = dot_row64(K + row * DM + head * 64, q);
                sm_update(s, V + row * DM + head * 64, mx, l, o);
            }
        }
        st_row64(Y + (rb + t) * YP + 384 + hm * 64, o, 1.f / l);
    }
}
__device__ __forceinline__ void dil_simple(Frame& F, const bf16* Q, const bf16* K, const bf16* V, bf16* Y) {
    const int gtid = F.bid * (NWAVES * 64) + F.tid, NT = F.G * NWAVES * 64;
    for (int g = gtid; g < BATCH * 2 * SEQ; g += NT) {
        const int b = g / (2 * SEQ), hg = (g / SEQ) & 1, t = g % SEQ; const size_t rb = (size_t)b * SEQ;
        float q[64], o[64];
#pragma unroll
        for (int d = 0; d < 64; ++d) o[d] = 0.f;
        float mx = -INFINITY, l = 0.f;
        for (int grp = 0; grp < 3; ++grp) {
            const int head = 4 + 2 * grp + hg, dil = grp == 0 ? 1 : (grp == 1 ? 4 : 16);
            ld_row64(Q + (rb + t) * DM + head * 64, q);
            for (int n = 0; n <= 128; ++n) {
                const int kp = t - n * dil; if (kp < 0) break;
                const size_t row = rb + kp;
                const float s = dot_row64(K + row * DM + head * 64, q);
                sm_update(s, V + row * DM + head * 64, mx, l, o);
            }
        }
        st_row64(Y + (rb + t) * YP + 256 + hg * 64, o, 1.f / l);
    }
}

#ifndef FP8_UP_FROM_LAYER
#define FP8_UP_FROM_LAYER 1
#endif
#ifndef FP8_DOWN_FROM_LAYER
#define FP8_DOWN_FROM_LAYER 1
#endif
#ifndef ROUTED_MOBA
#define ROUTED_MOBA 1
#endif
#ifndef FAST_MOBA
#define FAST_MOBA 1
#endif
#ifndef FAST_FOX
#define FAST_FOX 1
#endif
#ifndef FAST_DIL
#define FAST_DIL 1
#endif
constexpr size_t WS_OD = 400 * MiB;
constexpr size_t WS_LSE = 5 * MiB;
constexpr int CW_LCNT = 16384;
constexpr int CW_RQ = 20480;
constexpr size_t WS_PO = 424 * MiB;
constexpr size_t OUT_PL = 64 * MiB;
constexpr size_t OUT_XN8 = 80 * MiB;
constexpr size_t OUT_LIST = 68 * MiB;
constexpr int PRE_OFF = 102400;
constexpr int CW_STAT = 14336;
constexpr int CW_Q = 8192;
__device__ __forceinline__ void q_prefetch(Frame& F, unsigned* ctr, int& pre) {
    if (F.tid == 0) pre = (int)__hip_atomic_fetch_add(ctr + 64 * (int)(xb_xcc_id() & 7u), 1u, __ATOMIC_RELAXED, __HIP_MEMORY_SCOPE_AGENT);
}
__device__ __forceinline__ int q_take(Frame& F, unsigned* ctr, int nper, int pre) {
    LAS int* qw = (LAS int*)(F.lds + RING_OFF + attn_body::LDS_TAB + 384);
    if (F.tid == 0) {
        const int x = (int)(xb_xcc_id() & 7u); int res = -1;
        if (pre < nper) res = x * nper + pre;
        else for (int k = 1; k < 8; ++k) { const int xx = (x + k) & 7; const int id = (int)__hip_atomic_fetch_add(ctr + 64 * xx, 1u, __ATOMIC_RELAXED, __HIP_MEMORY_SCOPE_AGENT); if (id < nper) { res = xx * nper + id; break; } }
        *qw = res;
    }
    asm volatile("s_waitcnt lgkmcnt(0)\n\ts_barrier" ::: "memory");
    const int id = *qw;
    asm volatile("s_waitcnt lgkmcnt(0)\n\ts_barrier" ::: "memory");
    return __builtin_amdgcn_readfirstlane(id);
}
__device__ __forceinline__ void moba_fast(Frame& F, char* shm, unsigned* ctr, const bf16* Q, const bf16* K, const bf16* V, const float* KMP, bf16* Y) {
    int pre = 0; q_prefetch(F, ctr, pre);
    for (;;) { const int i = q_take(F, ctr, 96, pre); if (i < 0) break; q_prefetch(F, ctr, pre);
        const int xx = i / 96, id = i % 96, sidx = xx * 3 + (id % 3), qb = 31 - (id / 3), b = sidx / 6, hm = sidx % 6, head = 10 + hm;       const size_t rb = (size_t)b * SEQ;
        attn_body::UnitP U; U.Qh = Q + rb * DM + head * 64; U.Kh = K + rb * DM + head * 64; U.Vh = V + rb * DM + head * 64; U.Oh = Y + rb * YP + 384 + hm * 64; U.opitch = YP; U.rs = 1; U.q0 = qb * 256;
        U.t0 = 0; U.NT = 4; U.bias = nullptr; U.kmp = KMP + (size_t)(b * 32) * 2048 + head * 64; U.own = qb; U.lse = nullptr;
        attn_body::attn_unit<1, 8>(U, shm); }
}
__device__ __forceinline__ void fox_fast(Frame& F, char* shm, unsigned* ctr, const bf16* Q, const bf16* K, const bf16* V, const bf16* BIASK, const float* BIASC, const unsigned* stat, bf16* Y) {
    int pre = 0; q_prefetch(F, ctr, pre);
    for (;;) { const int i = q_take(F, ctr, 64, pre); if (i < 0) break; q_prefetch(F, ctr, pre);
        const int xx = i / 64, id = i % 64, sidx = xx * 2 + (id >> 5), qb = 31 - (id & 31), b = sidx >> 2, h = sidx & 3; const size_t rb = (size_t)b * SEQ;
        const float* bc = BIASC + ((size_t)b * 4 + h) * SEQ; const int q0 = qb * 256;
        const unsigned* sq = stat + ((b * 2 + 0) * 4 + h) * 2; const unsigned* sk = stat + ((b * 2 + 1) * 4 + h) * 2;
        const float q2 = __uint_as_float(sq[0]) + __uint_as_float(sq[1]), k2 = __uint_as_float(sk[0]) + __uint_as_float(sk[1]);
        const float lim = bc[q0] - (2.f * sqrtf(q2 * k2) + 42.f);
        const int pos = 64 * (2 * F.lane + 2) - 1; const bool ok = (pos < q0) && (bc[pos < q0 ? pos : 0] <= lim);
        const int tmin = 2 * __builtin_popcountll(__ballot(ok));
        attn_body::UnitP U; U.Qh = Q + rb * DM + h * 64; U.Kh = K + rb * DM + h * 64; U.Vh = V + rb * DM + h * 64; U.Oh = Y + rb * YP + h * 64; U.opitch = YP; U.rs = 1; U.q0 = q0;
        U.t0 = __builtin_amdgcn_readfirstlane(tmin); U.NT = 4 * qb + 4 - U.t0; U.bias = BIASK + ((size_t)b * 4 + h) * SEQ * 8; U.kmp = nullptr; U.own = 0; U.lse = nullptr;
        attn_body::attn_unit<0, 8>(U, shm); }
}
__device__ __forceinline__ void dil_fast(Frame& F, char* shm, unsigned* ctr, const bf16* Q, const bf16* K, const bf16* V, bf16* OD, float* LSE) {
    int pre = 0; q_prefetch(F, ctr, pre);
    for (;;) { const int i = q_take(F, ctr, 96, pre); if (i < 0) break; q_prefetch(F, ctr, pre);
        const int b = i / 192, rem = i % 192, hd = rem >> 5, ur = rem & 31, g2 = 2 * (hd >> 1), dil = 1 << g2, r = ur & (dil - 1), sb = ur >> g2, head = 4 + hd; const size_t rb = (size_t)b * SEQ + r;
        attn_body::UnitP U; U.Qh = Q + rb * DM + head * 64; U.Kh = K + rb * DM + head * 64; U.Vh = V + rb * DM + head * 64; U.Oh = OD + rb * 384 + hd * 64; U.opitch = 384; U.rs = dil; U.q0 = sb * 256;
        U.t0 = sb > 0 ? 4 * sb - 2 : 0; U.NT = 4 * sb + 4 - U.t0; U.bias = nullptr; U.kmp = nullptr; U.own = 0; U.lse = LSE + rb * 6 + hd; U.lsep = 6;
        attn_body::attn_unit<2, 8>(U, shm); }
}
__device__ __forceinline__ void moba_gate_pass(Frame& F, char* shm, unsigned* ctr, const bf16* Q, const bf16* K, const bf16* V, const float* KMP, unsigned* lcnt_g, unsigned short* LISTS, float* PL, bf16* Y) {
    int pre = 0; q_prefetch(F, ctr, pre);
    for (;;) { const int i = q_take(F, ctr, 96, pre); if (i < 0) break; q_prefetch(F, ctr, pre);
        const int xx = i / 96, id = i % 96, sidx = xx * 3 + (id % 3), qb = 31 - (id / 3), b = sidx / 6, hm = sidx % 6, head = 10 + hm; const size_t rb = (size_t)b * SEQ;
        attn_body::UnitP U; U.Qh = Q + rb * DM + head * 64; U.Kh = K + rb * DM + head * 64; U.Vh = V + rb * DM + head * 64; U.Oh = Y + rb * YP + 384 + hm * 64; U.opitch = YP; U.rs = 1; U.q0 = qb * 256;
        U.t0 = 4 * qb; U.NT = 4; U.bias = nullptr; U.kmp = KMP + (size_t)(b * 32) * 2048 + head * 64; U.own = qb; U.lse = PL + (rb * 6 + hm) * 4 + 3; U.lsep = 24;
        U.list = nullptr; U.cnt = 0; U.e0 = 0; U.PO = nullptr; U.PL = nullptr; U.rowbase6 = 0; U.glcnt = lcnt_g + (b * 6 + hm) * 32; U.glist = LISTS + (size_t)((b * 6 + hm) * 32) * 8192;
        attn_body::attn_unit<6, 8>(U, shm); }
}
__device__ __forceinline__ void moba_routed_pass(Frame& F, char* shm, unsigned* rq, const unsigned* lcnt_g, const unsigned short* LISTS, const bf16* Q, const bf16* K, const bf16* V, bf16* PO, float* PL) {
    LAS int* pre = (LAS int*)(F.lds + RING_OFF + PRE_OFF);
    { const int i0 = F.tid, i1 = F.tid + 512;
      const int n0_ = (int)lcnt_g[(i0 % 24) * 32 + i0 / 24]; int n1_ = 0; if (i1 < 768) n1_ = (int)lcnt_g[(i1 % 24) * 32 + i1 / 24];
      pre[i0] = (n0_ + 2047) >> 11; pre[896 + i0] = n0_; if (i1 < 768) { pre[i1] = (n1_ + 2047) >> 11; pre[896 + i1] = n1_; }
      __syncthreads();
      if (F.tid < 64) { int run = 0;
#pragma unroll 1
          for (int j = 0; j < 12; ++j) { const int idx = F.tid * 12 + j; run += pre[idx]; pre[idx] = run; } }
      __syncthreads();
      if (F.tid == 0) { int run = 0;
#pragma unroll 1
          for (int s = 0; s < 64; ++s) { const int e = pre[s * 12 + 11]; pre[768 + s] = run; run += e; } }
      __syncthreads();
      { const int a0 = pre[768 + i0 / 12]; int a1 = 0; if (i1 < 768) a1 = pre[768 + i1 / 12]; __syncthreads(); pre[i0] += a0; if (i1 < 768) pre[i1] += a1; }
      __syncthreads(); }
    const int NU = pre[767];
    LAS int* qw = pre + 2048;
    int nxt = 0;
    if (F.tid == 0) nxt = (int)__hip_atomic_fetch_add(rq, 1u, __ATOMIC_RELAXED, __HIP_MEMORY_SCOPE_AGENT);
    for (;;) {
        if (F.tid == 0) *qw = nxt;
        asm volatile("s_waitcnt lgkmcnt(0)\n\ts_barrier" ::: "memory");
        const int i = __builtin_amdgcn_readfirstlane(*qw);
        asm volatile("s_waitcnt lgkmcnt(0)\n\ts_barrier" ::: "memory");
        if (i >= NU) break;
        if (F.tid == 0) nxt = (int)__hip_atomic_fetch_add(rq, 1u, __ATOMIC_RELAXED, __HIP_MEMORY_SCOPE_AGENT);
        int lo = 0, hi_ = 767;
        while (lo < hi_) { const int mid = (lo + hi_) >> 1; if (pre[mid] > i) hi_ = mid; else lo = mid + 1; }
        const int j = lo, part = i - (j > 0 ? pre[j - 1] : 0), n = j / 24, bh = j % 24, L = bh * 32 + n, b = bh / 6, hm = bh % 6, head = 10 + hm; const size_t rb = (size_t)b * SEQ;
        const int len = __builtin_amdgcn_readfirstlane(pre[896 + j]); const int e0 = part * 2048, e1 = min(len, e0 + 2048);
        attn_body::routed_stat_unit<8>(Q + rb * DM + head * 64, K + rb * DM + head * 64, V + rb * DM + head * 64, LISTS + (size_t)L * 8192, e0, e1, n, PO, PL, (int)(rb * 6) + hm, shm);
    }
}
__device__ __forceinline__ void moba_combine(Frame& F, const bf16* PO, const float* PL, bf16* Y) {
    const int gtid = F.bid * (NWAVES * 64) + F.tid, NT = F.G * NWAVES * 64;
    struct It { f32x4 l4; v4u o, a, b, c; int ns; GAS v4u* yp; };
    auto ld = [&](It& I, int it) {
        const int m = it / 48, rem = it % 48, hm = rem >> 3, d0 = (rem & 7) * 8; I.ns = min(3, (m & (SEQ - 1)) >> 8);
        const size_t qi = (size_t)m * 6 + hm; I.l4 = __builtin_nontemporal_load((const GAS f32x4*)(PL + qi * 4));
        I.yp = (GAS v4u*)(Y + (size_t)m * YP + 384 + hm * 64 + d0); I.o = *I.yp; const v4u z = (v4u){0u, 0u, 0u, 0u};
        I.a = I.ns > 0 ? __builtin_nontemporal_load((const GAS v4u*)(PO + (qi * 3 + 0) * 64 + d0)) : z; I.b = I.ns > 1 ? __builtin_nontemporal_load((const GAS v4u*)(PO + (qi * 3 + 1) * 64 + d0)) : z; I.c = I.ns > 2 ? __builtin_nontemporal_load((const GAS v4u*)(PO + (qi * 3 + 2) * 64 + d0)) : z; };
    auto fin = [&](const It& I) {
        const float l0 = I.ns > 0 ? I.l4.x : -INFINITY, l1 = I.ns > 1 ? I.l4.y : -INFINITY, l2 = I.ns > 2 ? I.l4.z : -INFINITY, lo = I.l4.w;
        const float mx = fmaxf(fmaxf(l0, l1), fmaxf(l2, lo));
        float w0 = __builtin_amdgcn_exp2f(l0 - mx), w1 = __builtin_amdgcn_exp2f(l1 - mx), w2 = __builtin_amdgcn_exp2f(l2 - mx), wo = __builtin_amdgcn_exp2f(lo - mx);
        const float inv = 1.f / ((w0 + w1) + (w2 + wo)); w0 *= inv; w1 *= inv; w2 *= inv; wo *= inv;
        const v4u o = I.o, a = I.a, b = I.b, c = I.c; v4u r;
        r.x = pk2(wo * bflo(o.x) + w0 * bflo(a.x) + w1 * bflo(b.x) + w2 * bflo(c.x), wo * bfhi(o.x) + w0 * bfhi(a.x) + w1 * bfhi(b.x) + w2 * bfhi(c.x));
        r.y = pk2(wo * bflo(o.y) + w0 * bflo(a.y) + w1 * bflo(b.y) + w2 * bflo(c.y), wo * bfhi(o.y) + w0 * bfhi(a.y) + w1 * bfhi(b.y) + w2 * bfhi(c.y));
        r.z = pk2(wo * bflo(o.z) + w0 * bflo(a.z) + w1 * bflo(b.z) + w2 * bflo(c.z), wo * bfhi(o.z) + w0 * bfhi(a.z) + w1 * bfhi(b.z) + w2 * bfhi(c.z));
        r.w = pk2(wo * bflo(o.w) + w0 * bflo(a.w) + w1 * bflo(b.w) + w2 * bflo(c.w), wo * bfhi(o.w) + w0 * bfhi(a.w) + w1 * bfhi(b.w) + w2 * bfhi(c.w));
        *I.yp = r; };
    for (int it = gtid; it < M * 48; it += 3 * NT) {
        It A, B, C; ld(A, it); const bool hb = it + NT < M * 48, hc = it + 2 * NT < M * 48; if (hb) ld(B, it + NT); if (hc) ld(C, it + 2 * NT);
        fin(A); if (hb) fin(B); if (hc) fin(C);
    }
}
__device__ __forceinline__ void dil_merge(Frame& F, const bf16* OD, const float* LSE, bf16* Y) {
    const int gtid = F.bid * (NWAVES * 64) + F.tid, NT = F.G * NWAVES * 64;
    for (int it = gtid; it < M * 16; it += NT) {
        const int m = it >> 4, c8 = it & 15, hg = c8 >> 3, d0 = (c8 & 7) * 8;
        const float l0 = LSE[(size_t)m * 6 + hg], l1 = LSE[(size_t)m * 6 + 2 + hg], l2 = LSE[(size_t)m * 6 + 4 + hg];
        const float mx = fmaxf(l0, fmaxf(l1, l2));
        float w0 = __builtin_amdgcn_exp2f(l0 - mx), w1 = __builtin_amdgcn_exp2f(l1 - mx), w2 = __builtin_amdgcn_exp2f(l2 - mx);
        const float inv = 1.f / (w0 + w1 + w2); w0 *= inv; w1 *= inv; w2 *= inv;
        const v4u a = __builtin_nontemporal_load((const GAS v4u*)(OD + (size_t)m * 384 + hg * 64 + d0)), b = __builtin_nontemporal_load((const GAS v4u*)(OD + (size_t)m * 384 + (2 + hg) * 64 + d0)), c = __builtin_nontemporal_load((const GAS v4u*)(OD + (size_t)m * 384 + (4 + hg) * 64 + d0));
        v4u o;
        o.x = pk2(w0 * bflo(a.x) + w1 * bflo(b.x) + w2 * bflo(c.x), w0 * bfhi(a.x) + w1 * bfhi(b.x) + w2 * bfhi(c.x));
        o.y = pk2(w0 * bflo(a.y) + w1 * bflo(b.y) + w2 * bflo(c.y), w0 * bfhi(a.y) + w1 * bfhi(b.y) + w2 * bfhi(c.y));
        o.z = pk2(w0 * bflo(a.z) + w1 * bflo(b.z) + w2 * bflo(c.z), w0 * bfhi(a.z) + w1 * bfhi(b.z) + w2 * bfhi(c.z));
        o.w = pk2(w0 * bflo(a.w) + w1 * bflo(b.w) + w2 * bflo(c.w), w0 * bfhi(a.w) + w1 * bfhi(b.w) + w2 * bfhi(c.w));
        *(GAS v4u*)(Y + (size_t)m * YP + 256 + hg * 64 + d0) = o;
    }
}

template <int OFF> __device__ __forceinline__ unsigned long long karg64() {
    unsigned long long v; auto kp = __builtin_amdgcn_kernarg_segment_ptr();
    asm volatile("s_load_dwordx2 %0, %1, %2\n\ts_waitcnt lgkmcnt(0)" : "=s"(v) : "s"(kp), "n"(OFF) : "memory");
    return v;
}
template <int OFF> __device__ __forceinline__ int karg32() {
    int v; auto kp = __builtin_amdgcn_kernarg_segment_ptr();
    asm volatile("s_load_dword %0, %1, %2\n\ts_waitcnt lgkmcnt(0)" : "=s"(v) : "s"(kp), "n"(OFF) : "memory");
    return v;
}
#define INP(i) ((const float*)(const GAS float*)karg64<8 * (i)>())
#define OUTP() ((float*)(GAS float*)karg64<144>())
#define WSP() ((unsigned char*)(GAS unsigned char*)karg64<152>())
#define WSB(off) ((bf16*)(WSP() + (off)))
#define WSF(off) ((float*)(WSP() + (off)))
#define WLAYER(l) ((const bf16*)(WSP() + WS_W + (size_t)(l) * W_LAYER_BYTES))

__global__ void __launch_bounds__(NWAVES * 64, 2) fwd_kernel(Args args_unused) {
    extern __shared__ __attribute__((aligned(16))) unsigned char lds[];
    Frame F;
    F.lds = (LAS unsigned char*)lds; F.tid = threadIdx.x; F.lane = F.tid & 63; F.wave = __builtin_amdgcn_readfirstlane(F.tid >> 6); F.G = gridDim.x; F.bid = blockIdx.x;
    for (int u = F.tid; u < (LDS_BYTES - LDSCTL_OFF) / 4; u += NWAVES * 64) ((LAS unsigned*)(F.lds + LDSCTL_OFF))[u] = 0u;
    __syncthreads();
    volatile LAS unsigned* MISC = (volatile LAS unsigned*)(F.lds + MISC_OFF);
    XcdBarrier bar = xcd_barrier_post((unsigned*)(WSP() + WS_CTL) + CW_BAR, MISC + 8);
    const int lo = karg32<160>(), hi = karg32<164>();
    int phase = 0;
#define PH_BEGIN if (phase >= lo && phase < hi) { { int t_ = threadIdx.x, b_ = blockIdx.x, g_ = gridDim.x; asm volatile("" : "+v"(t_), "+v"(b_), "+v"(g_)); \
        F.tid = t_; F.lane = t_ & 63; F.wave = __builtin_amdgcn_readfirstlane(t_ >> 6); F.bid = __builtin_amdgcn_readfirstlane(b_); F.G = __builtin_amdgcn_readfirstlane(g_); }
#define PH_END(dobar) if ((dobar) && phase + 1 < hi) xcd_barrier(bar); } ++phase;

    PH_BEGIN
    {
        const int gtid = F.bid * (NWAVES * 64) + F.tid, NT = F.G * NWAVES * 64;
        float* TAB = WSF(WS_TAB);
        for (int e = gtid; e < SEQ * 32; e += NT) {
            const int t = e >> 5, i = e & 31;
            const float inv = 1.0f / powf(10000.0f, (float)(2 * i) * (1.0f / 64.0f));
            const float ang = (float)t * inv;
            const double rev = (double)ang * 0.15915494309189535; const float fr = (float)(rev - __builtin_rint(rev));
            TAB[e] = __builtin_amdgcn_cosf(fr); TAB[SEQ * 32 + e] = __builtin_amdgcn_sinf(fr);
        }
        LAS float* scr = (LAS float*)(F.lds + RING_OFF + F.wave * 16384);
        const int gw = F.bid * NWAVES + F.wave, NGW = F.G * NWAVES;
        constexpr int I_QKV = 16 * 32, I_G = 16 * 96, I_BA = 4 * 32, I_BB = 2 * 32, I_BC = 6 * 32, I_O = 16 * 32, I_F = 16 * 88, I_D = 44 * 32, I_P = 4 * 32, I_PG = 16 * 32;
        constexpr int I_LAYER = 3 * I_QKV + I_G + I_BA + I_BB + I_BC + I_O + 2 * I_F + I_D + I_P + I_PG;
        for (int it = gw; it < DEPTH * I_LAYER; it += NGW) {
            const int l = it / I_LAYER; int r = it % I_LAYER;
            bf16* WL = (bf16*)(WSP() + WS_W + (size_t)l * W_LAYER_BYTES);
            if (r < 3 * I_QKV + I_G) {
                const float* w_in = INP(3) + (size_t)l * DM * WINC;
                if (r < I_QKV) { wconv_item(w_in, WINC, 0, 1024, WL + OW_IN, 1024, 0, MAP_ROPE, 0, scr, r, F.lane); continue; } r -= I_QKV;
                if (r < I_QKV) { wconv_item(w_in, WINC, 1024, 1024, WL + OW_IN, 1024, 0, MAP_ROPE, 1024, scr, r, F.lane); continue; } r -= I_QKV;
                if (r < I_QKV) { wconv_item(w_in, WINC, 2048, 1024, WL + OW_IN, 1024, 0, MAP_P8, 2048, scr, r, F.lane); continue; } r -= I_QKV;
                wconv8_item(w_in, WINC, 3076, 3072, (unsigned char*)(WL + OW_IN + (size_t)3072 * 1024), scr, r, F.lane); continue;
            }
            r -= 3 * I_QKV + I_G;
            if (r < I_BA) { wconv_item(INP(5) + (size_t)l * 256 * DM, DM, 0, 1024, WL + OW_BR, 1024, 0, MAP_P8, 0, scr, r, F.lane); continue; } r -= I_BA;
            if (r < I_BB) { wconv_item(INP(6) + (size_t)l * 128 * DM, DM, 0, 1024, WL + OW_BR, 1024, 256, MAP_P8, 0, scr, r, F.lane); continue; } r -= I_BB;
            if (r < I_BC) { wconv_item(INP(7) + (size_t)l * 384 * DM, DM, 0, 1024, WL + OW_BR, 1024, 384, MAP_P8, 0, scr, r, F.lane); continue; } r -= I_BC;
            if (r < I_O) { wconv_item(INP(8) + (size_t)l * DM * DM, DM, 0, 1024, WL + OW_OUT, 1024, 0, MAP_P8, 0, scr, r, F.lane); continue; } r -= I_O;
            if (r < I_F) { if (l >= FP8_UP_FROM_LAYER) wconv8_item(INP(11) + (size_t)l * DM * DFF, DFF, 0, DFF, (unsigned char*)(WL + OW_GU), scr, r, F.lane, 1024, 64.0f, MAP_GU0);
                           else wconv_item(INP(11) + (size_t)l * DM * DFF, DFF, 0, DFF, WL + OW_GU, 1024, 0, MAP_GU0, 0, scr, r, F.lane); continue; } r -= I_F;
            if (r < I_F) { if (l >= FP8_UP_FROM_LAYER) wconv8_item(INP(12) + (size_t)l * DM * DFF, DFF, 0, DFF, (unsigned char*)(WL + OW_GU), scr, r, F.lane, 1024, 64.0f, MAP_GU1);
                           else wconv_item(INP(12) + (size_t)l * DM * DFF, DFF, 0, DFF, WL + OW_GU, 1024, 0, MAP_GU1, 0, scr, r, F.lane); continue; } r -= I_F;
            if (r < I_D) { if (l >= FP8_DOWN_FROM_LAYER) wconv8_item(INP(13) + (size_t)l * DFF * DM, DM, 0, 1024, (unsigned char*)(WL + OW_DN), scr, r, F.lane, DFF, 64.0f);
                           else wconv_item(INP(13) + (size_t)l * DFF * DM, DM, 0, 1024, WL + OW_DN, DFF, 0, MAP_P8, 0, scr, r, F.lane); continue; } r -= I_D;
            if (r < I_P) { wconv_item(INP(15) + (size_t)l * PLED * DM, DM, 0, 1024, WL + OW_PP, 1280, 1024, MAP_P8, 0, scr, r, F.lane); continue; } r -= I_P;
            wconv_item(INP(16) + (size_t)l * DM * DM, DM, 0, 1024, WL + OW_PP, 1280, 0, MAP_P8, 0, scr, r, F.lane);
        }
        __syncthreads();
        pass_t0(F, INP(0), INP(2), INP(3), INP(4), WSB(WS_XN), WSF(WS_LS), (unsigned char*)OUTP() + OUT_XN8);
    }
    PH_END(true)

    for (int l = 0; l < DEPTH; ++l) {
        PH_BEGIN
        {
            scan_phase(F, WSF(WS_LS), WSF(WS_BIASC), WSB(WS_BIASK));
            pg8::Prob<1, 1024, 1024, 12, 0, 0, 0, 16, 16, 16> P{WSB(WS_XN), WLAYER(l) + OW_IN, F.G, F.bid};
            pg8::EpiQKV E{WSB(WS_Q), WSB(WS_K), WSB(WS_V), WSF(WS_TAB), WSF(WS_KMP), (unsigned*)(WSP() + WS_CTL) + CW_STAT + 64 * l};
            pg8::gemm_phase(F.lds + RING_OFF, P, E);
        }
        PH_END(true)
        PH_BEGIN
        {
            unsigned* qctr = (unsigned*)(WSP() + WS_CTL) + CW_Q + 64 * 8 * 3 * l;
#if ROUTED_MOBA
            moba_gate_pass(F, (char*)lds + RING_OFF, qctr, WSB(WS_Q), WSB(WS_K), WSB(WS_V), WSF(WS_KMP), (unsigned*)(WSP() + WS_CTL) + CW_LCNT + 1024 * l, (unsigned short*)((unsigned char*)OUTP() + OUT_LIST), (float*)((unsigned char*)OUTP() + OUT_PL), WSB(WS_Y));
#elif FAST_MOBA
            moba_fast(F, (char*)lds + RING_OFF, qctr, WSB(WS_Q), WSB(WS_K), WSB(WS_V), WSF(WS_KMP), WSB(WS_Y));
#else
            moba_simple(F, WSB(WS_Q), WSB(WS_K), WSB(WS_V), WSF(WS_KMP), WSB(WS_Y));
#endif
#if FAST_FOX
            fox_fast(F, (char*)lds + RING_OFF, qctr + 64 * 8, WSB(WS_Q), WSB(WS_K), WSB(WS_V), WSB(WS_BIASK), WSF(WS_BIASC), (const unsigned*)(WSP() + WS_CTL) + CW_STAT + 64 * l, WSB(WS_Y));
#else
            fox_simple(F, WSB(WS_Q), WSB(WS_K), WSB(WS_V), WSF(WS_BIASC), WSB(WS_Y));
#endif
#if FAST_DIL
            dil_fast(F, (char*)lds + RING_OFF, qctr + 64 * 16, WSB(WS_Q), WSB(WS_K), WSB(WS_V), WSB(WS_OD), WSF(WS_LSE));
#else
            dil_simple(F, WSB(WS_Q), WSB(WS_K), WSB(WS_V), WSB(WS_Y));
#endif
        }
        PH_END(true)
#if ROUTED_MOBA
        PH_BEGIN
        moba_routed_pass(F, (char*)lds + RING_OFF, (unsigned*)(WSP() + WS_CTL) + CW_RQ + 64 * l, (const unsigned*)(WSP() + WS_CTL) + CW_LCNT + 1024 * l,
                         (const unsigned short*)((unsigned char*)OUTP() + OUT_LIST), WSB(WS_Q), WSB(WS_K), WSB(WS_V), WSB(WS_PO), (float*)((unsigned char*)OUTP() + OUT_PL));
        PH_END(true)
#endif
        PH_BEGIN
        {
#if FAST_DIL
            dil_merge(F, WSB(WS_OD), WSF(WS_LSE), WSB(WS_Y));
#endif
#if ROUTED_MOBA
            moba_combine(F, WSB(WS_PO), (const float*)((unsigned char*)OUTP() + OUT_PL), WSB(WS_Y));
#endif
        }
        PH_END(true)
        PH_BEGIN
        {
            bf16* gs = WSB(WS_GATES) + (size_t)F.bid * 393216;
            { pg8::Prob<3, 512, 512, 4, 0, 0, 0, 8, 8, 8, 1024, true> P{(const bf16*)((unsigned char*)OUTP() + OUT_XN8), WLAYER(l) + OW_IN + (size_t)3072 * 1024, F.G, F.bid};
              pg8::EpiGateS E{gs, 1.0f / 64.0f}; pg8::gemm_phase(F.lds + RING_OFF, P, E); }
            { pg8::Prob<3, 1024, 1024, 4, 0, 256, 384, 4, 2, 6> P{WSB(WS_Y), WLAYER(l) + OW_BR, F.G, F.bid};
              pg8::EpiMergeS E{gs, WSB(WS_MERGED)}; pg8::gemm_phase(F.lds + RING_OFF, P, E); }
        }
        PH_END(true)
        PH_BEGIN
        {
            pg8::Prob<1, 1024, 1024, 4, 0, 0, 0, 16, 16, 16> P{WSB(WS_MERGED), WLAYER(l) + OW_OUT, F.G, F.bid};
            pg8::EpiPlain E{WSB(WS_Y3), 1024};
            pg8::gemm_phase(F.lds + RING_OFF, P, E);
        }
        PH_END(true)
        PH_BEGIN
        if (l == 0) pass_res<1, true, false>(F, WSB(WS_Y3), INP(0), DM, OUTP(), DM, INP(9) + l * DM, INP(10) + l * DM, WSB(WS_XN), 1024, nullptr, nullptr, nullptr, nullptr);
        else pass_res<1, false, false>(F, WSB(WS_Y3), OUTP(), DM, OUTP(), DM, INP(9) + l * DM, INP(10) + l * DM, l >= FP8_UP_FROM_LAYER ? nullptr : WSB(WS_XN), 1024, nullptr, nullptr, nullptr, nullptr, l >= FP8_UP_FROM_LAYER ? (unsigned char*)OUTP() + OUT_XN8 : nullptr);
        PH_END(true)
        PH_BEGIN
        {
            if (l >= FP8_UP_FROM_LAYER) { pg8::Prob<1, 512, 512, 22, 0, 0, 0, 8, 8, 8, 0, true> P{(const bf16*)((unsigned char*)OUTP() + OUT_XN8), WLAYER(l) + OW_GU, F.G, F.bid};
                if (l >= FP8_DOWN_FROM_LAYER) { pg8::EpiSwiGLU8 E{(unsigned char*)WSB(WS_FF), DFF, 1.0f / 64.0f}; pg8::gemm_phase(F.lds + RING_OFF, P, E); }
                else { pg8::EpiSwiGLU E{WSB(WS_FF), DFF, 1.0f / 64.0f}; pg8::gemm_phase(F.lds + RING_OFF, P, E); } }
            else { pg8::Prob<1, 1024, 1024, 22, 0, 0, 0, 16, 16, 16> P{WSB(WS_XN), WLAYER(l) + OW_GU, F.G, F.bid};
                if (l >= FP8_DOWN_FROM_LAYER) { pg8::EpiSwiGLU8 E{(unsigned char*)WSB(WS_FF), DFF, 1.0f}; pg8::gemm_phase(F.lds + RING_OFF, P, E); }
                else { pg8::EpiSwiGLU E{WSB(WS_FF), DFF, 1.0f}; pg8::gemm_phase(F.lds + RING_OFF, P, E); } }
        }
        PH_END(true)
        PH_BEGIN
        {
            if (l >= FP8_DOWN_FROM_LAYER) { pg8::Prob<1, DFF / 2, DFF / 2, 4, 0, 0, 0, 22, 22, 22, 0, true> P{WSB(WS_FF), WLAYER(l) + OW_DN, F.G, F.bid};
                pg8::EpiScaled E{WSB(WS_Y3), 1024, 1.0f / 256.0f}; pg8::gemm_phase(F.lds + RING_OFF, P, E); }
            else { pg8::Prob<1, DFF, DFF, 4, 0, 0, 0, 44, 44, 44> P{WSB(WS_FF), WLAYER(l) + OW_DN, F.G, F.bid}; pg8::EpiPlain E{WSB(WS_Y3), 1024}; pg8::gemm_phase(F.lds + RING_OFF, P, E); }
        }
        PH_END(true)
        PH_BEGIN
        pass_res<2, false, false>(F, WSB(WS_Y3), OUTP(), DM, WSB(WS_XBP), 1280, INP(14) + l * DM, nullptr, nullptr, 0, nullptr, nullptr, nullptr, INP(1) + (size_t)l * M * PLED);
        PH_END(true)
        PH_BEGIN
        {
            pg8::Prob<2, 1280, 1280, 4, 1024, 0, 0, 4, 16, 16> P{WSB(WS_XBP), WLAYER(l) + OW_PP, F.G, F.bid};
            pg8::EpiPLE E{WSB(WS_TSCR) + (size_t)F.bid * 65536, WSB(WS_Y3)};
            pg8::gemm_phase(F.lds + RING_OFF, P, E);
        }
        PH_END(true)
        PH_BEGIN
        if (l + 1 < DEPTH) pass_res<1, false, false>(F, WSB(WS_Y3), WSB(WS_XBP), 1280, OUTP(), DM, INP(17) + l * DM, INP(2) + (l + 1) * DM, WSB(WS_XN), 1024, INP(3) + (size_t)(l + 1) * DM * WINC, INP(4) + (l + 1) * 4, WSF(WS_LS), nullptr, (unsigned char*)OUTP() + OUT_XN8);
        else pass_res<0, false, true>(F, WSB(WS_Y3), WSB(WS_XBP), 1280, OUTP(), DM, INP(17) + l * DM, nullptr, nullptr, 0, nullptr, nullptr, nullptr, nullptr);
        PH_END(l + 1 < DEPTH)
    }
#undef PH_BEGIN
#undef PH_END
}

extern "C" void kernel_launch(void* const* d_in, const int* in_sizes, int n_in, void* d_out, int out_size, void* d_ws, size_t ws_size, hipStream_t stream) {
    static int grid = 0;
    if (grid == 0) {
        if (n_in != 18 || out_size != M * DM || ws_size < WS_END) { fprintf(stderr, "kernel_launch: unexpected shapes (n_in %d out %d ws %zu)\n", n_in, out_size, ws_size); grid = -1; return; }
        int dev = 0, cus = 0, per_cu = 0;
        if (hipGetDevice(&dev) != hipSuccess || hipDeviceGetAttribute(&cus, hipDeviceAttributeMultiprocessorCount, dev) != hipSuccess) { grid = -1; return; }
        if (hipFuncSetAttribute((const void*)fwd_kernel, hipFuncAttributeMaxDynamicSharedMemorySize, LDS_BYTES) != hipSuccess) { grid = -1; return; }
        if (hipOccupancyMaxActiveBlocksPerMultiprocessor(&per_cu, (const void*)fwd_kernel, NWAVES * 64, LDS_BYTES) != hipSuccess || per_cu < 1) { fprintf(stderr, "kernel_launch: occupancy query says %d\n", per_cu); }
        (void)hipGetLastError();
        grid = cus;
    }
    if (grid < 0) return;
    (void)hipMemsetAsync((char*)d_ws + WS_CTL, 0, CTL_ZERO_BYTES, stream);
    Args a{};
    for (int i = 0; i < 18; ++i) a.in[i] = (const float*)d_in[i];
    a.out = (float*)d_out; a.ws = (unsigned char*)d_ws; a.ph_lo = 0; a.ph_hi = 1000;
    hipLaunchKernelGGL(fwd_kernel, dim3(grid), dim3(NWAVES * 64), LDS_BYTES, stream, a);
}
```

```cpp
#include <hip/hip_runtime.h>
#include <cstdio>
#include <cstdint>

constexpr int BATCH = 4, SEQ = 8192, DM = 1024, DEPTH = 2, M = BATCH * SEQ;
constexpr int DFF = 2816, WINC = 6148, PLED = 256;
constexpr float RMS_EPS = 1e-6f;
constexpr float LOG2E = 1.4426950408889634f;
constexpr float C2 = 0.125f * 1.4426950408889634f;
constexpr int NWAVES = 8;
constexpr int YP = 1024;

namespace pg8 {
#define PG8_LAS __attribute__((address_space(3)))
typedef unsigned short bf16_t;
typedef short bf16x8 __attribute__((ext_vector_type(8)));
typedef float f32x4 __attribute__((ext_vector_type(4)));
typedef float f32x2 __attribute__((ext_vector_type(2)));
typedef unsigned u32x4 __attribute__((ext_vector_type(4)));
typedef unsigned u32x2 __attribute__((ext_vector_type(2)));
typedef int i32x4 __attribute__((ext_vector_type(4)));
typedef int i32x8 __attribute__((ext_vector_type(8)));
constexpr int BM = 256, BK = 64, HALF = 128, HTB = HALF * BK * 2, STAGE_BYTES = 8 * HTB, NXCD = 8, WGM = 4;

__host__ __device__ __forceinline__ int lds_byte(int r, int c) { const int st = (r >> 4) * 2 + (c >> 5), rr = r & 15, cc = c & 31, ob = rr * 64 + cc * 2; return st * 1024 + (ob ^ (((ob >> 9) & 1) << 5)); }
__host__ __device__ __forceinline__ void stage_rc(int b, int& R, int& C) { const int st = b / 1024, sb = b % 1024, swz = sb ^ (((sb >> 9) & 1) << 5); R = (st >> 1) * 16 + swz / 64; C = (st & 1) * 32 + (swz % 64) / 2; }

struct UnitG { int pm, pn, sub, ti; };

template <int NSUB, int LDA, int LDB, int NN, int K0A, int K0B, int K0C, int NTA, int NTB, int NTC, int SUBROW = 0, bool FP8 = false> struct Prob {
    static constexpr int lda = LDA, ldb = LDB, nM = 128, nN = NN; static constexpr bool fp8 = FP8;
    const bf16_t* A; const bf16_t* Bt; int G, c;
    __device__ __forceinline__ bool next(int i, UnitG& u) const {
        constexpr int nwg = nM * nN; const long L = (long)(i / NSUB) * G + c; if (L >= nwg) return false;
        int wgid = (int)L; { constexpr int q = nwg / NXCD, r = nwg % NXCD; const int xcd = wgid % NXCD, off = wgid / NXCD; wgid = (xcd < r ? xcd * (q + 1) : r * (q + 1) + (xcd - r) * q) + off; }
        constexpr int nig = WGM * nN; const int gid = wgid / nig, fm = gid * WGM;
        u.pm = fm + ((wgid % nig) % WGM); u.pn = (wgid % nig) / WGM; u.sub = i % NSUB; u.ti = i / NSUB; return true;
    }
    __device__ __forceinline__ void addr(const UnitG& u, const char*& a, const char*& b, int& nt) const {
        const int k0 = u.sub == 0 ? K0A : (u.sub == 1 ? K0B : K0C); nt = u.sub == 0 ? NTA : (u.sub == 1 ? NTB : NTC);
        a = (const char*)(A + (size_t)u.pm * BM * lda + k0); b = (const char*)(Bt + (size_t)(u.pn * BM + u.sub * SUBROW) * ldb + k0);
    }
};

__device__ __forceinline__ unsigned cvt_pk_bf16(float lo, float hi) { unsigned r; asm volatile("v_cvt_pk_bf16_f32 %0, %1, %2" : "=v"(r) : "v"(lo), "v"(hi)); return r; }
__device__ __forceinline__ float bf_lo(unsigned w) { return __uint_as_float(w << 16); }
__device__ __forceinline__ float bf_hi(unsigned w) { return __uint_as_float(w & 0xffff0000u); }
__device__ __forceinline__ float sigmoidf_(float x) { return __builtin_amdgcn_rcpf(1.0f + __builtin_amdgcn_exp2f(-x * LOG2E)); }


struct EpiPlain {
    bf16_t* O; int ldc;
    __device__ __forceinline__ bool operator()(f32x4 (&acc)[2][2][4][2], const UnitG& u, int wr, int wc, int fr, int fq) const {
        const int row0 = u.pm * BM + wr * 64 + fr, col0 = u.pn * BM + wc * 32 + 8 * fq;
#pragma unroll
        for (int ai = 0; ai < 2; ++ai)
#pragma unroll
            for (int m = 0; m < 4; ++m) { bf16_t* rowp = O + (size_t)(row0 + ai * HALF + m * 16) * ldc + col0;
#pragma unroll
                for (int bj = 0; bj < 2; ++bj) { const f32x4 v0 = acc[ai][bj][m][0], v1 = acc[ai][bj][m][1];
                    u32x4 w; w.x = cvt_pk_bf16(v0[0], v0[1]); w.y = cvt_pk_bf16(v0[2], v0[3]); w.z = cvt_pk_bf16(v1[0], v1[1]); w.w = cvt_pk_bf16(v1[2], v1[3]);
                    *(u32x4*)(rowp + bj * HALF) = w; } }
        return false;
    }
};
struct EpiGateS {
    bf16_t* S; float ascale;
    __device__ __forceinline__ bool operator()(f32x4 (&acc)[2][2][4][2], const UnitG& u, int wr, int wc, int fr, int fq) const {
        const int sub = u.sub; int tid = threadIdx.x; asm volatile("" : "+v"(tid)); const float nsc = -ascale * LOG2E;
        bf16_t* Sc = S + (size_t)(3 * u.ti + sub) * 65536 + tid * 8; bf16_t* Sp = Sc - (sub > 0 ? 65536 : 0);
#pragma unroll
        for (int hh = 0; hh < 2; ++hh) {
        u32x4 prev[8];
        if (sub > 0) {
#pragma unroll
            for (int g8 = 0; g8 < 8; ++g8) prev[g8] = *(const u32x4*)(Sp + (size_t)(hh * 8 + g8) * 4096);
        }
#pragma unroll
        for (int g8 = 0; g8 < 8; ++g8) { const int g = hh * 8 + g8, ai = g >> 3, m = (g >> 1) & 3, bj = g & 1;
            f32x4 v0 = acc[ai][bj][m][0], v1 = acc[ai][bj][m][1];
#pragma unroll
            for (int j = 0; j < 4; ++j) { v0[j] = fminf(1.0f + __builtin_amdgcn_exp2f(v0[j] * nsc), 1e30f); v1[j] = fminf(1.0f + __builtin_amdgcn_exp2f(v1[j] * nsc), 1e30f); }
            f32x4 p0 = v0, p1 = v1;
            if (sub == 2) {
#pragma unroll
                for (int j = 0; j < 4; ++j) { p0[j] = fminf(__builtin_amdgcn_rcpf(v0[j]), 1.0f); p1[j] = fminf(__builtin_amdgcn_rcpf(v1[j]), 1.0f); } }
            u32x4 w; w.x = cvt_pk_bf16(p0[0], p0[1]); w.y = cvt_pk_bf16(p0[2], p0[3]); w.z = cvt_pk_bf16(p1[0], p1[1]); w.w = cvt_pk_bf16(p1[2], p1[3]);
            *(u32x4*)(Sc + (size_t)g * 4096) = w;
            if (sub > 0) { const u32x4 p = prev[g8]; const float pv[8] = {bf_lo(p.x), bf_hi(p.x), bf_lo(p.y), bf_hi(p.y), bf_lo(p.z), bf_hi(p.z), bf_lo(p.w), bf_hi(p.w)};
                float r[8];
#pragma unroll
                for (int j = 0; j < 4; ++j) { r[j] = v0[j] * __builtin_amdgcn_rcpf(pv[j]); r[4 + j] = v1[j] * __builtin_amdgcn_rcpf(pv[4 + j]); }
                u32x4 q; q.x = cvt_pk_bf16(r[0], r[1]); q.y = cvt_pk_bf16(r[2], r[3]); q.z = cvt_pk_bf16(r[4], r[5]); q.w = cvt_pk_bf16(r[6], r[7]);
                *(u32x4*)(Sp + (size_t)g * 4096) = q; } }
        asm volatile("" ::: "memory"); }
        return false;
    }
};
struct EpiSwiGLU {
    bf16_t* O; int ldc; float isc;
    __device__ __forceinline__ bool operator()(f32x4 (&acc)[2][2][4][2], const UnitG& u, int wr, int wc, int fr, int fq) const {
        const int row0 = u.pm * BM + wr * 64 + fr, col0 = u.pn * HALF + wc * 32 + 8 * fq;
#pragma unroll
        for (int ai = 0; ai < 2; ++ai)
#pragma unroll
            for (int m = 0; m < 4; ++m) { bf16_t* rowp = O + (size_t)(row0 + ai * HALF + m * 16) * ldc + col0;
                f32x4 v0, v1;
#pragma unroll
                for (int j = 0; j < 4; ++j) { const float g0 = acc[ai][0][m][0][j] * isc, g1 = acc[ai][0][m][1][j] * isc;
                    v0[j] = g0 * sigmoidf_(g0) * (acc[ai][1][m][0][j] * isc); v1[j] = g1 * sigmoidf_(g1) * (acc[ai][1][m][1][j] * isc); }
                u32x4 w; w.x = cvt_pk_bf16(v0[0], v0[1]); w.y = cvt_pk_bf16(v0[2], v0[3]); w.z = cvt_pk_bf16(v1[0], v1[1]); w.w = cvt_pk_bf16(v1[2], v1[3]);
                *(u32x4*)rowp = w; }
        return false;
    }
};
struct EpiSwiGLU8 {
    unsigned char* O; int ldc; float isc;
    __device__ __forceinline__ bool operator()(f32x4 (&acc)[2][2][4][2], const UnitG& u, int wr, int wc, int fr, int fq) const {
        const int row0 = u.pm * BM + wr * 64 + fr, col0 = u.pn * HALF + wc * 32 + 8 * fq;
#pragma unroll
        for (int ai = 0; ai < 2; ++ai)
#pragma unroll
            for (int m = 0; m < 4; ++m) { unsigned char* rowp = O + (size_t)(row0 + ai * HALF + m * 16) * ldc + col0;
                f32x4 v0, v1;
#pragma unroll
                for (int j = 0; j < 4; ++j) { const float g0 = acc[ai][0][m][0][j] * isc, g1 = acc[ai][0][m][1][j] * isc;
                    v0[j] = g0 * sigmoidf_(g0) * (acc[ai][1][m][0][j] * isc) * 4.0f; v1[j] = g1 * sigmoidf_(g1) * (acc[ai][1][m][1][j] * isc) * 4.0f; }
                unsigned w0 = 0u, w1 = 0u;
                w0 = __builtin_amdgcn_cvt_pk_fp8_f32(v0[0], v0[1], w0, false); w0 = __builtin_amdgcn_cvt_pk_fp8_f32(v0[2], v0[3], w0, true);
                w1 = __builtin_amdgcn_cvt_pk_fp8_f32(v1[0], v1[1], w1, false); w1 = __builtin_amdgcn_cvt_pk_fp8_f32(v1[2], v1[3], w1, true);
                u32x2 w; w.x = w0; w.y = w1; *(u32x2*)rowp = w; }
        return false;
    }
};
struct EpiScaled {
    bf16_t* O; int ldc; float sc;
    __device__ __forceinline__ bool operator()(f32x4 (&acc)[2][2][4][2], const UnitG& u, int wr, int wc, int fr, int fq) const {
        const int row0 = u.pm * BM + wr * 64 + fr, col0 = u.pn * BM + wc * 32 + 8 * fq;
#pragma unroll
        for (int ai = 0; ai < 2; ++ai)
#pragma unroll
            for (int m = 0; m < 4; ++m) { bf16_t* rowp = O + (size_t)(row0 + ai * HALF + m * 16) * ldc + col0;
#pragma unroll
                for (int bj = 0; bj < 2; ++bj) { const f32x4 v0 = acc[ai][bj][m][0] * sc, v1 = acc[ai][bj][m][1] * sc;
                    u32x4 w; w.x = cvt_pk_bf16(v0[0], v0[1]); w.y = cvt_pk_bf16(v0[2], v0[3]); w.z = cvt_pk_bf16(v1[0], v1[1]); w.w = cvt_pk_bf16(v1[2], v1[3]);
                    *(u32x4*)(rowp + bj * HALF) = w; } }
        return false;
    }
};
struct EpiQKV {
    bf16_t *Q, *K, *V; const float* cs; float* kmp; unsigned* stat;
    __device__ __forceinline__ bool operator()(f32x4 (&acc)[2][2][4][2], const UnitG& u, int wr, int wc, int fr, int fq) const {
        const int sec = u.pn >> 2, pt = u.pn & 3;
        const int row0 = u.pm * BM + wr * 64 + fr;
        if (sec == 2) {
            const int col0 = pt * BM + wc * 32 + 8 * fq;
#pragma unroll
            for (int ai = 0; ai < 2; ++ai)
#pragma unroll
                for (int m = 0; m < 4; ++m) { bf16_t* rowp = V + (size_t)(row0 + ai * HALF + m * 16) * DM + col0;
#pragma unroll
                    for (int bj = 0; bj < 2; ++bj) { const f32x4 v0 = acc[ai][bj][m][0], v1 = acc[ai][bj][m][1];
                        u32x4 w; w.x = cvt_pk_bf16(v0[0], v0[1]); w.y = cvt_pk_bf16(v0[2], v0[3]); w.z = cvt_pk_bf16(v1[0], v1[1]); w.w = cvt_pk_bf16(v1[2], v1[3]);
                        *(u32x4*)(rowp + bj * HALF) = w; } }
        } else {
            bf16_t* dst = sec == 0 ? Q : K; const float sc = sec == 0 ? C2 : 1.0f; const bool rope = pt >= 1;
            const int dlo = 16 * (wc & 1) + 4 * fq;
            f32x4 ks[2][2]; float nmx[2] = {0.f, 0.f};
#pragma unroll
            for (int a = 0; a < 2; ++a)
#pragma unroll
                for (int b = 0; b < 2; ++b) ks[a][b] = (f32x4){0.f, 0.f, 0.f, 0.f};
            const float* csb = cs + (size_t)(row0 & (SEQ - 1)) * 32 + dlo;
            f32x4 cb = (f32x4){1.f, 1.f, 1.f, 1.f}, sb = (f32x4){0.f, 0.f, 0.f, 0.f}, c16 = cb, s16 = sb, c128 = cb, s128 = sb;
            if (rope) { cb = *(const f32x4*)csb; sb = *(const f32x4*)(csb + (size_t)SEQ * 32); c16 = *(const f32x4*)(cs + 16 * 32 + dlo); s16 = *(const f32x4*)(cs + (size_t)SEQ * 32 + 16 * 32 + dlo);
                c128 = *(const f32x4*)(cs + 128 * 32 + dlo); s128 = *(const f32x4*)(cs + (size_t)SEQ * 32 + 128 * 32 + dlo); }
            f32x4 c = cb, s = sb;
#pragma unroll
            for (int it = 0; it < 8; ++it) { const int ai = it >> 2, m = it & 3; const int row = row0 + ai * HALF + m * 16;
                if (it == 4) { c = cb * c128 - sb * s128; s = sb * c128 + cb * s128; }
                else if (it > 0) { const f32x4 cn = c * c16 - s * s16; s = s * c16 + c * s16; c = cn; }
#pragma unroll
                for (int bj = 0; bj < 2; ++bj) { const int head = 4 * pt + 2 * bj + (wc >> 1);
                    const f32x4 x1 = acc[ai][bj][m][0], x2 = acc[ai][bj][m][1];
                    const f32x4 o1 = (x1 * c - x2 * s) * sc, o2 = (x2 * c + x1 * s) * sc;
                    if (sec == 1 && pt >= 2) { ks[bj][0] += o1; ks[bj][1] += o2; }
                    if (pt == 0) { float ps = (o1[0] * o1[0] + o1[1] * o1[1]) + (o1[2] * o1[2] + o1[3] * o1[3]) + (o2[0] * o2[0] + o2[1] * o2[1]) + (o2[2] * o2[2] + o2[3] * o2[3]);
                        ps += __shfl_xor(ps, 16); ps += __shfl_xor(ps, 32); nmx[bj] = fmaxf(nmx[bj], ps); }
                    bf16_t* p = dst + (size_t)row * DM + head * 64 + dlo;
                    u32x2 w1, w2; w1.x = cvt_pk_bf16(o1[0], o1[1]); w1.y = cvt_pk_bf16(o1[2], o1[3]); w2.x = cvt_pk_bf16(o2[0], o2[1]); w2.y = cvt_pk_bf16(o2[2], o2[3]);
                    *(u32x2*)p = w1; *(u32x2*)(p + 32) = w2; }
                asm volatile("" : "+v"(ks[0][0]), "+v"(ks[0][1]), "+v"(ks[1][0]), "+v"(ks[1][1]) :: "memory"); }
            if (pt == 0) {
#pragma unroll
                for (int bj = 0; bj < 2; ++bj) { float x = nmx[bj]; x = fmaxf(x, __shfl_xor(x, 1)); x = fmaxf(x, __shfl_xor(x, 2)); x = fmaxf(x, __shfl_xor(x, 4)); x = fmaxf(x, __shfl_xor(x, 8));
                    if ((threadIdx.x & 63) == 0) __hip_atomic_fetch_max(stat + (((u.pm >> 5) * 2 + sec) * 4 + 2 * bj + (wc >> 1)) * 2 + (wc & 1), __float_as_uint(x), __ATOMIC_RELAXED, __HIP_MEMORY_SCOPE_AGENT); }
            }
            if (sec == 1 && pt >= 2) {
#pragma unroll
                for (int bj = 0; bj < 2; ++bj)
#pragma unroll
                    for (int n = 0; n < 2; ++n) { f32x4 v = ks[bj][n];
#pragma unroll
                        for (int j = 0; j < 4; ++j) { float x = v[j]; x += __shfl_xor(x, 1); x += __shfl_xor(x, 2); x += __shfl_xor(x, 4); x += __shfl_xor(x, 8); v[j] = x; }
                        if (fr == 0) { const int head = 4 * pt + 2 * bj + (wc >> 1); *(f32x4*)(kmp + ((size_t)u.pm * 2 + wr) * DM + head * 64 + dlo + 32 * n) = v; } }
            }
        }
        return false;
    }
};
struct EpiMergeS {
    const bf16_t* S; bf16_t* O;
    __device__ __forceinline__ bool operator()(f32x4 (&acc)[2][2][4][2], const UnitG& u, int wr, int wc, int fr, int fq) const {
        const int row0 = u.pm * BM + wr * 64 + fr, col0 = u.pn * BM + wc * 32 + 8 * fq; const int sub = u.sub; int tid = threadIdx.x; asm volatile("" : "+v"(tid));
        const bf16_t* Sc = S + (size_t)(3 * u.ti + sub) * 65536 + tid * 8;
        u32x4 gv[16];
#pragma unroll
        for (int g = 0; g < 16; ++g) gv[g] = __builtin_nontemporal_load((const u32x4*)(Sc + (size_t)g * 4096));
#pragma unroll
        for (int g = 0; g < 16; ++g) { const int ai = g >> 3, m = (g >> 1) & 3, bj = g & 1; const u32x4 g1 = gv[g];
            const float r[8] = {bf_lo(g1.x), bf_hi(g1.x), bf_lo(g1.y), bf_hi(g1.y), bf_lo(g1.z), bf_hi(g1.z), bf_lo(g1.w), bf_hi(g1.w)};
            f32x4 v0 = acc[ai][bj][m][0], v1 = acc[ai][bj][m][1];
#pragma unroll
            for (int j = 0; j < 4; ++j) { v0[j] *= r[j]; v1[j] *= r[4 + j]; }
            acc[ai][bj][m][0] = v0; acc[ai][bj][m][1] = v1;
            if (sub == 2) { u32x4 w; w.x = cvt_pk_bf16(v0[0], v0[1]); w.y = cvt_pk_bf16(v0[2], v0[3]); w.z = cvt_pk_bf16(v1[0], v1[1]); w.w = cvt_pk_bf16(v1[2], v1[3]);
                *(u32x4*)(O + (size_t)(row0 + ai * HALF + m * 16) * DM + col0 + bj * HALF) = w; } }
        return sub < 2;
    }
};
struct EpiPLE {
    bf16_t* T; bf16_t* O;
    __device__ __forceinline__ bool operator()(f32x4 (&acc)[2][2][4][2], const UnitG& u, int wr, int wc, int fr, int fq) const {
        const int row0 = u.pm * BM + wr * 64 + fr, col0 = u.pn * BM + wc * 32 + 8 * fq; int tid = threadIdx.x; asm volatile("" : "+v"(tid));
        if (u.sub == 0) {
#pragma unroll
            for (int g = 0; g < 16; ++g) { const int ai = g >> 3, m = (g >> 1) & 3, bj = g & 1; const f32x4 v0 = acc[ai][bj][m][0], v1 = acc[ai][bj][m][1];
                int tt = tid; asm volatile("" : "+v"(tt));
                u32x4 w; w.x = cvt_pk_bf16(v0[0], v0[1]); w.y = cvt_pk_bf16(v0[2], v0[3]); w.z = cvt_pk_bf16(v1[0], v1[1]); w.w = cvt_pk_bf16(v1[2], v1[3]); *(u32x4*)(T + (size_t)g * 4096 + tt * 8) = w; }
        } else {
#pragma unroll
            for (int hh = 0; hh < 2; ++hh) {
                u32x4 tv8[8]; int tt = tid, r0 = row0; asm volatile("" : "+v"(tt), "+v"(r0));
#pragma unroll
                for (int g8 = 0; g8 < 8; ++g8) tv8[g8] = *(const u32x4*)(T + (size_t)(hh * 8 + g8) * 4096 + tt * 8);
#pragma unroll
                for (int g8 = 0; g8 < 8; ++g8) { const int g = hh * 8 + g8, ai = g >> 3, m = (g >> 1) & 3, bj = g & 1; const u32x4 t = tv8[g8];
                    const float tv[8] = {bf_lo(t.x), bf_hi(t.x), bf_lo(t.y), bf_hi(t.y), bf_lo(t.z), bf_hi(t.z), bf_lo(t.w), bf_hi(t.w)};
                    f32x4 v0 = acc[ai][bj][m][0], v1 = acc[ai][bj][m][1];
#pragma unroll
                    for (int j = 0; j < 4; ++j) { v0[j] = tv[j] * sigmoidf_(v0[j]); v1[j] = tv[4 + j] * sigmoidf_(v1[j]); }
                    u32x4 w; w.x = cvt_pk_bf16(v0[0], v0[1]); w.y = cvt_pk_bf16(v0[2], v0[3]); w.z = cvt_pk_bf16(v1[0], v1[1]); w.w = cvt_pk_bf16(v1[2], v1[3]);
                    *(u32x4*)(O + (size_t)(r0 + ai * HALF + m * 16) * DM + col0 + bj * HALF) = w; }
                asm volatile("" ::: "memory"); }
        }
        return false;
    }
};

template <class Epi, class ProbT>
__device__ __forceinline__ void gemm_phase(PG8_LAS unsigned char* lds, const ProbT& P, const Epi& E) {
    int tid_ = threadIdx.x; asm volatile("" : "+v"(tid_));
    const int tid = tid_, wid = __builtin_amdgcn_readfirstlane(tid >> 6), lane = tid & 63, wr = wid >> 2, wc = wid & 3, fr = lane & 15, fq = lane >> 4;
    unsigned voffA[2], voffB[2];
#pragma unroll
    for (int i = 0; i < 2; ++i) { int R, C; stage_rc(tid * 16 + i * 8192, R, C); voffA[i] = (unsigned)(R * ProbT::lda + C) * 2u; voffB[i] = (unsigned)(R * ProbT::ldb + C) * 2u; }
    if constexpr (ProbT::fp8) { *(PG8_LAS u32x4*)(lds + STAGE_BYTES + 2048 + tid * 16) = (u32x4){voffA[0], voffA[1], voffB[0], voffB[1]}; asm volatile("s_waitcnt lgkmcnt(0)" ::: "memory"); }
    constexpr size_t kstep = (size_t)(BK * 2);
    constexpr size_t hstepA = (size_t)HALF * ProbT::lda * 2, hstepB = (size_t)HALF * ProbT::ldb * 2;
    const unsigned ldsw = (unsigned)wid * 1024u;
    const int aoff = lds_byte(wr * 64 + fr, fq * 8), boff = lds_byte(wc * 32 + fr, fq * 8);
    PG8_LAS unsigned char* ldsA = lds + aoff; PG8_LAS unsigned char* ldsB = lds + 4 * HTB + boff;
#define PG8_SA(b, h) (((b) * 2 + (h)) * HTB)
#define PG8_SB(b, h) ((4 + (b) * 2 + (h)) * HTB)
#define PG8_STAGE(bufoff, gbase, voff) do { unsigned vo_[2]; if constexpr (ProbT::fp8) { const u32x4 q_ = *(const PG8_LAS u32x4*)(lds + STAGE_BYTES + 2048 + tid * 16); vo_[0] = (&(voff)[0] == &voffA[0]) ? q_.x : q_.z; vo_[1] = (&(voff)[0] == &voffA[0]) ? q_.y : q_.w; } \
        else { vo_[0] = (voff)[0]; vo_[1] = (voff)[1]; } \
        _Pragma("unroll") for (int _i = 0; _i < 2; ++_i) \
        __builtin_amdgcn_global_load_lds((const unsigned*)((const char*)(gbase) + vo_[_i]), (PG8_LAS unsigned*)(lds + (bufoff) + ldsw + _i * 8192), 16, 0, 0); } while (0)
#define PG8_RD16A(off) (*(const PG8_LAS i32x4*)(ldsA + (off)))
#define PG8_LDA(dst, b, h) do { if constexpr (ProbT::fp8) { _Pragma("unroll") for (int m = 0; m < 4; ++m) dst##8[m] = __builtin_shufflevector(PG8_RD16A(PG8_SA(b, h) + m * 2048), PG8_RD16A(PG8_SA(b, h) + m * 2048 + 1024), 0, 1, 2, 3, 4, 5, 6, 7); } \
        else { _Pragma("unroll") for (int m = 0; m < 4; ++m) _Pragma("unroll") for (int k = 0; k < 2; ++k) dst[m][k] = *(const PG8_LAS bf16x8*)(ldsA + PG8_SA(b, h) + m * 2048 + k * 1024); } } while (0)
#define PG8_SBR(b, h) (((b) * 2 + (h)) * HTB)
#define PG8_RD16B(off) (*(const PG8_LAS i32x4*)(ldsB + (off)))
#define PG8_LDB(dst, b, h) do { if constexpr (ProbT::fp8) { _Pragma("unroll") for (int n = 0; n < 2; ++n) dst##8[n] = __builtin_shufflevector(PG8_RD16B(PG8_SBR(b, h) + n * 2048), PG8_RD16B(PG8_SBR(b, h) + n * 2048 + 1024), 0, 1, 2, 3, 4, 5, 6, 7); } \
        else { _Pragma("unroll") for (int n = 0; n < 2; ++n) _Pragma("unroll") for (int k = 0; k < 2; ++k) dst[n][k] = *(const PG8_LAS bf16x8*)(ldsB + PG8_SBR(b, h) + n * 2048 + k * 1024); } } while (0)
#define PG8_MMA(ai, bj, At, Bt) do { __builtin_amdgcn_s_setprio(1); \
        if constexpr (ProbT::fp8) { _Pragma("unroll") for (int m = 0; m < 4; ++m) _Pragma("unroll") for (int n = 0; n < 2; ++n) \
            acc[ai][bj][m][n] = __builtin_amdgcn_mfma_scale_f32_16x16x128_f8f6f4(Bt##8[n], At##8[m], acc[ai][bj][m][n], 0, 0, 0, 0x7f7f7f7f, 0, 0x7f7f7f7f); } \
        else { _Pragma("unroll") for (int m = 0; m < 4; ++m) _Pragma("unroll") for (int n = 0; n < 2; ++n) _Pragma("unroll") for (int k = 0; k < 2; ++k) \
            acc[ai][bj][m][n] = __builtin_amdgcn_mfma_f32_16x16x32_bf16(Bt[n][k], At[m][k], acc[ai][bj][m][n], 0, 0, 0); } \
        __builtin_amdgcn_s_setprio(0); } while (0)
#define PG8_WAIT_V(n) asm volatile("s_waitcnt vmcnt(" #n ")" ::: "memory")
#define PG8_WAIT_L(n) asm volatile("s_waitcnt lgkmcnt(" #n ")" ::: "memory")
#define PG8_BAR __builtin_amdgcn_s_barrier()
#define PG8_SCHED __builtin_amdgcn_sched_barrier(0)
    UnitG cur, nxt; int ui = 0;
    if (!P.next(0, cur)) return;
    f32x4 acc[2][2][4][2];
#pragma unroll
    for (int a = 0; a < 2; ++a)
#pragma unroll
        for (int b = 0; b < 2; ++b)
#pragma unroll
            for (int m = 0; m < 4; ++m)
#pragma unroll
                for (int n = 0; n < 2; ++n) acc[a][b][m][n] = (f32x4){0.f, 0.f, 0.f, 0.f};
    bf16x8 At[4][2], B0[2][2], B1[2][2]; i32x8 At8[4], B08[2], B18[2];
    const char* cA; const char* cB; int nt; P.addr(cur, cA, cB, nt);
    PG8_STAGE(PG8_SB(0, 0), cB, voffB); PG8_STAGE(PG8_SB(0, 1), cB + hstepB, voffB); PG8_STAGE(PG8_SA(0, 0), cA, voffA); PG8_STAGE(PG8_SA(0, 1), cA + hstepA, voffA);
    if (wr == 1) PG8_BAR;
    PG8_WAIT_V(2); PG8_BAR;
    PG8_STAGE(PG8_SB(1, 0), cB + kstep, voffB); PG8_STAGE(PG8_SA(1, 0), cA + kstep, voffA); PG8_STAGE(PG8_SB(1, 1), cB + hstepB + kstep, voffB);
    PG8_WAIT_V(6); PG8_BAR;
    for (;;) {
        const bool has_next = P.next(ui + 1, nxt);
        const char* nA = cA; const char* nB = cB; int nnt = nt;
        if (has_next) P.addr(nxt, nA, nB, nnt);
#pragma clang loop unroll(disable)
        for (int t = 0; t < nt; t += 2) {
            const bool last = (t == nt - 2);
            const char* a1 = cA + (size_t)(t + 1) * kstep;
            const char* a2 = last ? nA : cA + (size_t)(t + 2) * kstep; const char* b2 = last ? nB : cB + (size_t)(t + 2) * kstep;
            const char* a3 = a2 + kstep; const char* b3 = b2 + kstep;
            PG8_LDB(B0, 0, 0); PG8_LDB(B1, 0, 1); PG8_SCHED; PG8_LDA(At, 0, 0); PG8_STAGE(PG8_SA(1, 1), a1 + hstepA, voffA);
            PG8_WAIT_V(8); PG8_WAIT_L(0); PG8_BAR; PG8_MMA(0, 0, At, B0); PG8_MMA(0, 1, At, B1); PG8_BAR; PG8_SCHED;
            PG8_LDA(At, 0, 1); PG8_STAGE(PG8_SB(0, 0), b2, voffB); PG8_STAGE(PG8_SB(0, 1), b2 + hstepB, voffB); PG8_STAGE(PG8_SA(0, 0), a2, voffA);
            PG8_WAIT_V(8); PG8_WAIT_L(0); PG8_BAR; PG8_MMA(1, 0, At, B0); PG8_MMA(1, 1, At, B1); PG8_BAR; PG8_SCHED;
            PG8_LDB(B0, 1, 0); PG8_LDB(B1, 1, 1); PG8_SCHED; PG8_LDA(At, 1, 0); PG8_STAGE(PG8_SA(0, 1), a2 + hstepA, voffA);
            PG8_WAIT_V(8); PG8_WAIT_L(0); PG8_BAR; PG8_MMA(0, 0, At, B0); PG8_MMA(0, 1, At, B1); PG8_BAR; PG8_SCHED;
            PG8_LDA(At, 1, 1); PG8_STAGE(PG8_SB(1, 0), b3, voffB); PG8_STAGE(PG8_SB(1, 1), b3 + hstepB, voffB); PG8_STAGE(PG8_SA(1, 0), a3, voffA);
            PG8_WAIT_V(8); PG8_WAIT_L(0); PG8_BAR; PG8_MMA(1, 0, At, B0); PG8_MMA(1, 1, At, B1); PG8_BAR; PG8_SCHED;
        }
        if (wr == 0) PG8_BAR;
        int t2_ = threadIdx.x; asm volatile("" : "+v"(t2_)); const int w2_ = __builtin_amdgcn_readfirstlane(t2_ >> 6);
        const bool keep = E(acc, cur, w2_ >> 2, w2_ & 3, t2_ & 15, (t2_ & 63) >> 4);
        if (!has_next) break;
        if (!keep) {
#pragma unroll
            for (int a = 0; a < 2; ++a)
#pragma unroll
                for (int b = 0; b < 2; ++b)
#pragma unroll
                    for (int m = 0; m < 4; ++m)
#pragma unroll
                        for (int n = 0; n < 2; ++n) acc[a][b][m][n] = (f32x4){0.f, 0.f, 0.f, 0.f};
        }
        cur = nxt; cA = nA; cB = nB; nt = nnt; ++ui;
        if (wr == 1) PG8_BAR;
    }
    PG8_WAIT_V(0);
    PG8_BAR;
#undef PG8_SA
#undef PG8_SB
#undef PG8_STAGE
#undef PG8_LDA
#undef PG8_LDB
#undef PG8_MMA
#undef PG8_RD16A
#undef PG8_RD16B
#undef PG8_SBR
#undef PG8_WAIT_V
#undef PG8_WAIT_L
#undef PG8_BAR
#undef PG8_SCHED
}
}

constexpr size_t MiB = 1u << 20;
constexpr size_t WS_CTL = 0, CTL_ZERO_BYTES = 128 * 1024;
constexpr size_t WS_TAB = 1 * MiB;
constexpr size_t WS_KMP = 3 * MiB;
constexpr size_t WS_LS = 4 * MiB;
constexpr size_t WS_BIASC = 4 * MiB + 512 * 1024;
constexpr size_t WS_BIASK = 6 * MiB;
constexpr size_t WS_W = 8 * MiB, W_LAYER_BYTES = 35 * MiB;
constexpr size_t OW_IN = 0, OW_BR = 6291456, OW_OUT = 7340032, OW_GU = 8388608, OW_DN = 14155776, OW_PP = 17039360, OW_END = 18350080;
static_assert(OW_END * 2 <= W_LAYER_BYTES, "weights");
constexpr size_t WS_XN = 80 * MiB;
constexpr size_t WS_Q = 144 * MiB, WS_K = 208 * MiB, WS_V = 272 * MiB;
constexpr size_t WS_GATES = 144 * MiB;
constexpr size_t WS_Y3 = 144 * MiB;
constexpr size_t WS_FF = 208 * MiB;
constexpr size_t WS_Y = 336 * MiB;
constexpr size_t WS_XBP = 384 * MiB;
constexpr size_t WS_MERGED = 440 * MiB;
constexpr size_t WS_TSCR = 464 * MiB;
constexpr size_t WS_END = 504 * MiB;
constexpr int CW_BAR = 1024;

constexpr int RING_OFF = 0, RING_BYTES = 131072;
constexpr int LDSCTL_OFF = RING_BYTES + 12288, MISC_OFF = LDSCTL_OFF + 320;
constexpr int LDS_BYTES = 147456;

#define GAS __attribute__((address_space(1)))
#define LAS __attribute__((address_space(3)))
typedef unsigned short bf16;
typedef unsigned v4u __attribute__((ext_vector_type(4)));
typedef unsigned v2u __attribute__((ext_vector_type(2)));
typedef float f32x4 __attribute__((ext_vector_type(4)));
typedef GAS unsigned gu32;
#define LDS_WAIT() asm volatile("s_waitcnt lgkmcnt(0)" ::: "memory")
#define VM_WAIT() asm volatile("s_waitcnt vmcnt(0)" ::: "memory")
__device__ __forceinline__ unsigned f2bf(float f) { unsigned u = __builtin_bit_cast(unsigned, f); return (u + 0x7fffu + ((u >> 16) & 1u)) >> 16; }
__device__ __forceinline__ unsigned pk2(float lo, float hi) { return f2bf(lo) | (f2bf(hi) << 16); }
__device__ __forceinline__ float bflo(unsigned w) { return __uint_as_float(w << 16); }
__device__ __forceinline__ float bfhi(unsigned w) { return __uint_as_float(w & 0xffff0000u); }

#define XB_TMO      128
#define XB_XCNT(j)  (256  + 64 * (j))
#define XB_XSUB(j)  (1280 + 64 * (j))
#define XB_XGEN(j)  (2304 + 64 * (j))
#define XB_TOP      3328
#define XB_TOPGEN   3392
#define XCD_BAR_WORDS 3456
#define XB_SPIN_CAP (1u << 18)
__device__ __forceinline__ unsigned xb_ld(unsigned* p)              { return __hip_atomic_load(p, __ATOMIC_RELAXED, __HIP_MEMORY_SCOPE_AGENT); }
__device__ __forceinline__ unsigned xb_add(unsigned* p, unsigned v) { return __hip_atomic_fetch_add(p, v, __ATOMIC_RELAXED, __HIP_MEMORY_SCOPE_AGENT); }
__device__ __forceinline__ unsigned xb_xcc_id() { return (unsigned)__builtin_amdgcn_s_getreg((3 << 11) | 20) & 0xFu; }
#define XB_SPIN(cond, bar) do { unsigned _sp = 0; while (cond) { __builtin_amdgcn_s_sleep(1); \
    if ((++_sp & 255u) == 0u) { if (xb_ld(&(bar)[XB_TMO])) break; if (_sp > XB_SPIN_CAP) { atomicAdd(&(bar)[XB_TMO], 1u); break; } } } } while (0)
struct XcdBarrier { unsigned* bar; unsigned x; volatile LAS unsigned* st; };
__device__ __forceinline__ XcdBarrier xcd_barrier_post(unsigned* bar, volatile LAS unsigned* st) {
    XcdBarrier b; b.bar = bar; b.x = xb_xcc_id(); b.st = st;
    if (threadIdx.x == 0) (void)xb_add(&bar[XB_XCNT(b.x)], 1u);
    return b;
}
__device__ __forceinline__ void xcd_barrier_complete(unsigned* bar, unsigned x, unsigned& nloc, unsigned& nx) {
    const unsigned G = gridDim.x * gridDim.y * gridDim.z;
    unsigned sum, cnt, mine, sp = 0u;
    for (;;) {
        sum = 0u; cnt = 0u; mine = 0u;
#pragma unroll
        for (unsigned j = 0; j < 16; ++j) { const unsigned c = xb_ld(&bar[XB_XCNT(j)]); sum += c; cnt += (c > 0u) ? 1u : 0u; mine = (j == x) ? c : mine; }
        if (sum == G) break;
        __builtin_amdgcn_s_sleep(1);
        if ((++sp & 255u) == 0u) { if (xb_ld(&bar[XB_TMO])) break; if (sp > XB_SPIN_CAP) { atomicAdd(&bar[XB_TMO], 1u); break; } }
    }
    nloc = mine > 0u ? mine : 1u; nx = cnt > 0u ? cnt : 1u;
}
__device__ __forceinline__ void xcd_barrier(const XcdBarrier& b) {
    asm volatile("s_waitcnt vmcnt(0)" ::: "memory");
    __syncthreads();
    if (threadIdx.x == 0) {
        unsigned* bar = b.bar; asm volatile("" : "+s"(bar));
        __builtin_amdgcn_s_waitcnt(0);
        unsigned nloc = b.st[0], nx = b.st[1];
        unsigned bx = b.x; asm volatile("" : "+s"(bx));
        if (nloc == 0u) { xcd_barrier_complete(bar, bx, nloc, nx); b.st[0] = nloc; b.st[1] = nx; }
        const unsigned old = xb_add(&bar[XB_XSUB(bx)], 1u);
        const unsigned gen = old / nloc;
        if (old + 1u == (gen + 1u) * nloc) {
            __builtin_amdgcn_fence(__ATOMIC_RELEASE, "agent");
            asm volatile("s_waitcnt vmcnt(0)" ::: "memory");
            const unsigned og = xb_add(&bar[XB_TOP], 1u);
            const unsigned tg = og / nx;
            if (og + 1u == (tg + 1u) * nx) xb_add(&bar[XB_TOPGEN], 1u);
            else XB_SPIN(xb_ld(&bar[XB_TOPGEN]) == tg, bar);
            __builtin_amdgcn_fence(__ATOMIC_ACQUIRE, "agent");
            xb_add(&bar[XB_XGEN(bx)], 1u);
            asm volatile("s_waitcnt vmcnt(0)" ::: "memory");
        } else {
            XB_SPIN(xb_ld(&bar[XB_XGEN(bx)]) == gen, bar);
            __builtin_amdgcn_fence(__ATOMIC_ACQUIRE, "agent");
            asm volatile("s_waitcnt vmcnt(0)" ::: "memory");
        }
    }
    __syncthreads();
}

struct Args { const float* in[18]; float* out; unsigned char* ws; int ph_lo, ph_hi; };
struct Frame {
    LAS unsigned char* lds; int tid, lane, wave, G, bid;
};

__device__ __forceinline__ float wave_sum(float v) {
#pragma unroll
    for (int o = 1; o < 64; o <<= 1) v += __shfl_xor(v, o);
    return v;
}

enum { MAP_P8 = 0, MAP_ROPE = 1, MAP_GU0 = 2, MAP_GU1 = 3 };
__device__ __forceinline__ int p8inv(int c) { return 16 * ((c >> 2) & 1) + 4 * (c >> 3) + (c & 3); }
__device__ __forceinline__ int rowmap(int kind, int n) {
    if (kind == MAP_ROPE) { const int d = n & 63; return (n & ~63) + 32 * ((d >> 4) & 1) + 16 * (d >> 5) + (d & 15); }
    if (kind == MAP_P8) return (n & ~31) + p8inv(n & 31);
    return 256 * (n >> 7) + (kind == MAP_GU1 ? 128 : 0) + (n & 96) + p8inv(n & 31);
}
__device__ __forceinline__ void wconv_item(const float* W, int ldw, int col0, int N, bf16* WT, int ldt, int koff, int kind, int rowoff, LAS float* scr, int item, int lane) {
    const int nblk = N / 32, kb = item / nblk, nb = item % nblk, k0 = 64 * kb, n0 = 32 * nb;
    float wv[32];
#pragma unroll
    for (int i = 0; i < 32; ++i) { const int kk = 2 * i + (lane >> 5); wv[i] = __builtin_nontemporal_load(W + (size_t)(k0 + kk) * ldw + col0 + n0 + (lane & 31)); }
#pragma unroll
    for (int i = 0; i < 32; ++i) { const int kk = 2 * i + (lane >> 5); scr[kk * 33 + (lane & 31)] = wv[i]; }
    LDS_WAIT(); asm volatile("" ::: "memory");
    const int c = lane & 7;
#pragma unroll
    for (int j = 0; j < 4; ++j) { const int n = (lane >> 3) + 8 * j; const LAS float* s = scr + (8 * c) * 33 + n;
        v4u o; o.x = pk2(s[0 * 33], s[1 * 33]); o.y = pk2(s[2 * 33], s[3 * 33]); o.z = pk2(s[4 * 33], s[5 * 33]); o.w = pk2(s[6 * 33], s[7 * 33]);
        __builtin_nontemporal_store(o, (GAS v4u*)(WT + (size_t)(rowoff + rowmap(kind, n0 + n)) * ldt + koff + k0 + 8 * c)); }
    LDS_WAIT(); asm volatile("" ::: "memory");
}

__device__ __forceinline__ void wconv8_item(const float* W, int ldw, int col0, int N, unsigned char* WT8, LAS float* scr, int item, int lane, int ldt8 = 1024, float scale = 64.0f, int kind = MAP_P8) {
    const int nblk = N / 32, kb = item / nblk, nb = item % nblk, k0 = 64 * kb, n0 = 32 * nb;
    float wv[32];
#pragma unroll
    for (int i = 0; i < 32; ++i) { const int kk = 2 * i + (lane >> 5); wv[i] = __builtin_nontemporal_load(W + (size_t)(k0 + kk) * ldw + col0 + n0 + (lane & 31)); }
#pragma unroll
    for (int i = 0; i < 32; ++i) { const int kk = 2 * i + (lane >> 5); scr[kk * 33 + (lane & 31)] = wv[i] * scale; }
    LDS_WAIT(); asm volatile("" ::: "memory");
    const int c = lane & 7;
#pragma unroll
    for (int j = 0; j < 4; ++j) { const int n = (lane >> 3) + 8 * j; const LAS float* s = scr + (8 * c) * 33 + n;
        unsigned w0 = 0u, w1 = 0u;
        w0 = __builtin_amdgcn_cvt_pk_fp8_f32(s[0 * 33], s[1 * 33], w0, false); w0 = __builtin_amdgcn_cvt_pk_fp8_f32(s[2 * 33], s[3 * 33], w0, true);
        w1 = __builtin_amdgcn_cvt_pk_fp8_f32(s[4 * 33], s[5 * 33], w1, false); w1 = __builtin_amdgcn_cvt_pk_fp8_f32(s[6 * 33], s[7 * 33], w1, true);
        v2u o; o.x = w0; o.y = w1;
        __builtin_nontemporal_store(o, (GAS v2u*)(WT8 + (size_t)rowmap(kind, n0 + n) * ldt8 + k0 + 8 * c)); }
    LDS_WAIT(); asm volatile("" ::: "memory");
}

__device__ __forceinline__ float log_sigmoid(float f) { return fminf(f, 0.f) - __logf(1.f + __expf(-fabsf(f))); }

__device__ __forceinline__ void row_norm_out(const f32x4 (&v)[4], const f32x4 (&g)[4], bf16* xnrow, int lane, const LAS float* wf, const float* bf, float* lsrow, unsigned char* x8row = nullptr) {
    float ss = 0.f;
#pragma unroll
    for (int j = 0; j < 4; ++j) ss += (v[j].x * v[j].x + v[j].y * v[j].y) + (v[j].z * v[j].z + v[j].w * v[j].w);
    const float r = rsqrtf(wave_sum(ss) * (1.f / DM) + RMS_EPS);
    f32x4 h[4];
#pragma unroll
    for (int j = 0; j < 4; ++j) h[j] = v[j] * r * g[j];
    if (xnrow) { GAS v2u* o8 = (GAS v2u*)xnrow + lane;
#pragma unroll
        for (int j = 0; j < 4; ++j) { v2u w; w.x = pk2(h[j].x, h[j].y); w.y = pk2(h[j].z, h[j].w); o8[64 * j] = w; } }
    if (x8row) {
#pragma unroll
        for (int j = 0; j < 4; ++j) { unsigned w = 0u; w = __builtin_amdgcn_cvt_pk_fp8_f32(h[j].x, h[j].y, w, false); w = __builtin_amdgcn_cvt_pk_fp8_f32(h[j].z, h[j].w, w, true); *((GAS unsigned*)x8row + lane + 64 * j) = w; } }
    if (lsrow) {
        f32x4 f = (f32x4){0.f, 0.f, 0.f, 0.f};
#pragma unroll
        for (int j = 0; j < 4; ++j) { const LAS f32x4* wp = (const LAS f32x4*)wf + (4 * lane + 256 * j);
            f += wp[0] * h[j].x; f += wp[1] * h[j].y; f += wp[2] * h[j].z; f += wp[3] * h[j].w; }
        f.x = wave_sum(f.x); f.y = wave_sum(f.y); f.z = wave_sum(f.z); f.w = wave_sum(f.w);
        if (lane == 0) { f32x4 o; o.x = log_sigmoid(f.x + bf[0]); o.y = log_sigmoid(f.y + bf[1]); o.z = log_sigmoid(f.z + bf[2]); o.w = log_sigmoid(f.w + bf[3]); *(GAS f32x4*)lsrow = o; }
    }
}
__device__ __forceinline__ void load_wf(Frame& F, const float* w_in_l) {
    LAS f32x4* wf = (LAS f32x4*)(F.lds + RING_OFF);
    for (int k = F.tid; k < DM; k += NWAVES * 64) wf[k] = *(const GAS f32x4*)(w_in_l + (size_t)k * WINC + 3072);
    __syncthreads();
}
__device__ __forceinline__ void pass_t0(Frame& F, const float* x, const float* g_pre, const float* w_in_l, const float* bf, bf16* XN, float* LS, unsigned char* XN8) {
    load_wf(F, w_in_l);
    f32x4 g[4];
#pragma unroll
    for (int j = 0; j < 4; ++j) g[j] = *((const GAS f32x4*)g_pre + F.lane + 64 * j);
    const int gw = F.bid * NWAVES + F.wave, NGW = F.G * NWAVES;
    f32x4 va[4], vb[4];
    auto ld0 = [&](f32x4 (&v)[4], int m) {
#pragma unroll
        for (int j = 0; j < 4; ++j) v[j] = __builtin_nontemporal_load((const GAS f32x4*)(x + (size_t)m * DM) + F.lane + 64 * j); };
    if (gw < M) ld0(va, gw);
    if (gw + NGW < M) ld0(vb, gw + NGW);
    for (int m = gw; m < M; m += 2 * NGW) {
        { f32x4 v[4];
#pragma unroll
          for (int j = 0; j < 4; ++j) v[j] = va[j];
          if (m + 2 * NGW < M) ld0(va, m + 2 * NGW);
          row_norm_out(v, g, XN + (size_t)m * DM, F.lane, (const LAS float*)(F.lds + RING_OFF), bf, LS + (size_t)m * 4, XN8 + (size_t)m * DM); }
        if (m + NGW < M) { f32x4 v[4];
#pragma unroll
          for (int j = 0; j < 4; ++j) v[j] = vb[j];
          if (m + 3 * NGW < M) ld0(vb, m + 3 * NGW);
          row_norm_out(v, g, XN + (size_t)(m + NGW) * DM, F.lane, (const LAS float*)(F.lds + RING_OFF), bf, LS + (size_t)(m + NGW) * 4, XN8 + (size_t)(m + NGW) * DM); }
    }
    __syncthreads();
}
template <int MODE, bool XI_F32, bool XO_F32>
__device__ __forceinline__ void pass_res(Frame& F, const bf16* Y, const void* xi, int ldi, void* xo, int ldo, const float* g_post, const float* g_next, bf16* XN, int ldn,
                                         const float* w_in_l, const float* bf, float* LS, const float* prow, unsigned char* XN8 = nullptr) {
    const bool do_ls = (MODE == 1) && (LS != nullptr);
    if (do_ls) load_wf(F, w_in_l);
    f32x4 gp[4], gn[4];
#pragma unroll
    for (int j = 0; j < 4; ++j) { gp[j] = *((const GAS f32x4*)g_post + F.lane + 64 * j); if (MODE == 1) gn[j] = *((const GAS f32x4*)g_next + F.lane + 64 * j); else gn[j] = gp[j]; }
    const int gw = F.bid * NWAVES + F.wave, NGW = F.G * NWAVES;
    struct RowBuf { v2u yr[4]; f32x4 xr4[4]; v2u xr2[4]; f32x4 pr; };
    auto ld_row = [&](RowBuf& R, int m) {
#pragma unroll
        for (int j = 0; j < 4; ++j) { R.yr[j] = __builtin_nontemporal_load((const GAS v2u*)(Y + (size_t)m * DM) + F.lane + 64 * j);
            if (XI_F32) R.xr4[j] = __builtin_nontemporal_load((const GAS f32x4*)((const float*)xi + (size_t)m * ldi) + F.lane + 64 * j);
            else R.xr2[j] = __builtin_nontemporal_load((const GAS v2u*)((const bf16*)xi + (size_t)m * ldi) + F.lane + 64 * j); }
        if (MODE == 2) R.pr = __builtin_nontemporal_load((const GAS f32x4*)(prow + (size_t)m * PLED) + F.lane); };
    auto do_row = [&](const RowBuf& R, int m) {
        f32x4 y[4], v[4];
#pragma unroll
        for (int j = 0; j < 4; ++j) { y[j] = (f32x4){bflo(R.yr[j].x), bfhi(R.yr[j].x), bflo(R.yr[j].y), bfhi(R.yr[j].y)};
            if (XI_F32) v[j] = R.xr4[j]; else v[j] = (f32x4){bflo(R.xr2[j].x), bfhi(R.xr2[j].x), bflo(R.xr2[j].y), bfhi(R.xr2[j].y)}; }
        float ss = 0.f;
#pragma unroll
        for (int j = 0; j < 4; ++j) ss += (y[j].x * y[j].x + y[j].y * y[j].y) + (y[j].z * y[j].z + y[j].w * y[j].w);
        const float r = rsqrtf(wave_sum(ss) * (1.f / DM) + RMS_EPS);
#pragma unroll
        for (int j = 0; j < 4; ++j) { v[j] = v[j] + y[j] * r * gp[j];
            if (XO_F32) __builtin_nontemporal_store(v[j], (GAS f32x4*)((float*)xo + (size_t)m * ldo) + F.lane + 64 * j);
            else { v2u w; w.x = pk2(v[j].x, v[j].y); w.y = pk2(v[j].z, v[j].w);
                if (MODE == 2) *((GAS v2u*)((bf16*)xo + (size_t)m * ldo) + F.lane + 64 * j) = w;
                else __builtin_nontemporal_store(w, (GAS v2u*)((bf16*)xo + (size_t)m * ldo) + F.lane + 64 * j); } }
        if (MODE == 1) row_norm_out(v, gn, XN ? XN + (size_t)m * ldn : nullptr, F.lane, (const LAS float*)(F.lds + RING_OFF), bf, do_ls ? LS + (size_t)m * 4 : nullptr, XN8 ? XN8 + (size_t)m * DM : nullptr);
        if (MODE == 2) { v2u w; w.x = pk2(R.pr.x, R.pr.y); w.y = pk2(R.pr.z, R.pr.w); *((GAS v2u*)((bf16*)xo + (size_t)m * ldo) + F.lane + 256) = w; } };
    RowBuf A, B;
    if (gw < M) ld_row(A, gw);
    if (gw + NGW < M) ld_row(B, gw + NGW);
    for (int m = gw; m < M; m += 2 * NGW) {
        do_row(A, m); if (m + 2 * NGW < M) ld_row(A, m + 2 * NGW);
        if (m + NGW < M) { do_row(B, m + NGW); if (m + 3 * NGW < M) ld_row(B, m + 3 * NGW); }
    }
    if (do_ls) __syncthreads();
}

__device__ __forceinline__ void scan_phase(Frame& F, const float* LS, float* BIASC, bf16* BIASK) {
    LAS float* wt = (LAS float*)(F.lds + RING_OFF);
    for (int s = F.bid; s < 16; s += F.G) {
        const int b = s >> 2, h = s & 3; const int t0 = F.tid * 16;
        float v[16]; float run = 0.f;
#pragma unroll
        for (int i = 0; i < 16; ++i) { run += LS[((size_t)b * SEQ + t0 + i) * 4 + h]; v[i] = run; }
        float inc = run;
#pragma unroll
        for (int o = 1; o < 64; o <<= 1) { const float n = __int_as_float(__builtin_amdgcn_ds_bpermute((F.lane - o) * 4, __float_as_int(inc))); if (F.lane >= o) inc += n; }
        if (F.lane == 63) wt[F.wave] = inc;
        __syncthreads();
        float base = inc - run;
        for (int w = 0; w < F.wave; ++w) base += wt[w];
#pragma unroll
        for (int i = 0; i < 16; ++i) { const float x = -(base + v[i]) * LOG2E; BIASC[((size_t)b * 4 + h) * SEQ + t0 + i] = x;
            const unsigned h1 = f2bf(x); const float r1 = x - __uint_as_float(h1 << 16); const unsigned h2 = f2bf(r1); const float r2 = r1 - __uint_as_float(h2 << 16); const unsigned h3 = f2bf(r2);
            v4u w; w.x = h1 | (h2 << 16); w.y = h3; w.z = 0u; w.w = 0u; *(GAS v4u*)(BIASK + (((size_t)b * 4 + h) * SEQ + t0 + i) * 8) = w; }
        __syncthreads();
    }
}

namespace attn_body {
using bf16x8=__attribute__((ext_vector_type(8)))short;
using s16x4=__attribute__((ext_vector_type(4)))short;
using f32x16=__attribute__((ext_vector_type(16)))float;
using u32x4=__attribute__((ext_vector_type(4)))unsigned;
typedef unsigned short bf16;
constexpr int D=64,DMQ=1024;
constexpr int NW=8,QBLK=32,QB=QBLK*NW,KVBLK=64;
__device__ __forceinline__ int crow(int r,int hi){return (r&3)+8*(r>>2)+4*hi;}
#define SBAR() __builtin_amdgcn_sched_barrier(0)
__device__ __forceinline__ void cmask(f32x16&p0,f32x16&p1,int jb,int qrel,int hi){
  const float NEG=-INFINITY; int kb=64*jb+4*hi;
  #pragma unroll
  for(int r=0;r<16;++r){int kv=kb+(r&3)+8*(r>>2); if(kv>qrel)p0[r]=NEG; if(kv+32>qrel)p1[r]=NEG;}
}
__device__ __forceinline__ void wmask(f32x16&p0,f32x16&p1,int kbrel,int qrel,int hi){
  const float NEG=-INFINITY; int qh=qrel-4*hi; asm volatile("":"+v"(qh));
  #pragma unroll
  for(int r=0;r<16;++r){const int kv=kbrel+(r&3)+8*(r>>2); if(kv>qh||kv+128<qh)p0[r]=NEG; if(kv+32>qh||kv+160<qh)p1[r]=NEG;}
}
constexpr int NSLOT=3, SLOTB=8192;
constexpr int LDS_K=0, LDS_V=NSLOT*SLOTB, LDS_WS=2*NSLOT*SLOTB, LDS_OST=LDS_WS+NW*64*4, LDS_BIAS=LDS_OST+NW*4096, LDS_TAB=LDS_BIAS+NSLOT*1024, LDS_BYTES=LDS_TAB+2048;
__device__ __forceinline__ void glds16(const void*gsrc,unsigned lds_dst){unsigned keep;
  asm volatile("s_mov_b32 %0, m0\n\ts_mov_b32 m0, %2\n\ts_nop 0\n\tglobal_load_lds_dwordx4 %1, off\n\ts_mov_b32 m0, %0":"=&s"(keep):"v"(gsrc),"s"(lds_dst):"memory");}
__device__ __forceinline__ void glds4(const void*gsrc,unsigned lds_dst){unsigned keep;
  asm volatile("s_mov_b32 %0, m0\n\ts_mov_b32 m0, %2\n\ts_nop 0\n\tglobal_load_lds_dword %1, off\n\ts_mov_b32 m0, %0":"=&s"(keep):"v"(gsrc),"s"(lds_dst):"memory");}
__device__ __forceinline__ float max3f(float a,float b,float c){float r;asm("v_max3_f32 %0, %1, %2, %3":"=v"(r):"v"(a),"v"(b),"v"(c));return r;}
__device__ __forceinline__ float max2f(float a,float b){float r;asm("v_max_f32_e32 %0, %1, %2":"=v"(r):"v"(a),"v"(b));return r;}
__device__ __forceinline__ float fadd_s(float a,float b){float r;asm("v_add_f32_e32 %0, %1, %2":"=v"(r):"v"(a),"v"(b));return r;}
__device__ __forceinline__ float fsub_s(float a,float b){float r;asm("v_sub_f32_e32 %0, %1, %2":"=v"(r):"v"(a),"v"(b));return r;}
typedef float f32x2_t __attribute__((ext_vector_type(2))); typedef __bf16 bf16x2_t __attribute__((ext_vector_type(2)));
__device__ __forceinline__ unsigned cvtpk_s(float lo,float hi){f32x2_t v={lo,hi};bf16x2_t b=__builtin_convertvector(v,bf16x2_t);return __builtin_bit_cast(unsigned,b);}
#define WAIT_BAR(N) asm volatile("s_waitcnt vmcnt(%0) lgkmcnt(0)\n\ts_barrier"::"n"(N):"memory")

__device__ __forceinline__ void qkt(f32x16&p0,f32x16&p1,const char*Kslot,const bf16x8*qr,const f32x16&c0,const f32x16&c1,int r32,int hi){
  const char*kb=Kslot+hi*1024+r32*16;
  #pragma unroll
  for(int d0=0;d0<4;++d0){
    const bf16x8 b0=*reinterpret_cast<const bf16x8*>(kb+d0*2048);
    const bf16x8 b1=*reinterpret_cast<const bf16x8*>(kb+d0*2048+512);
    if(d0==0){p0=__builtin_amdgcn_mfma_f32_32x32x16_bf16(b0,qr[0],c0,0,0,0);p1=__builtin_amdgcn_mfma_f32_32x32x16_bf16(b1,qr[0],c1,0,0,0);}
    else{p0=__builtin_amdgcn_mfma_f32_32x32x16_bf16(b0,qr[d0],p0,0,0,0);p1=__builtin_amdgcn_mfma_f32_32x32x16_bf16(b1,qr[d0],p1,0,0,0);}}
}
__device__ __forceinline__ int ksw_src_chunk(int lane,int wid){ return (lane&7)^((lane>>3)^(wid&1)); }
__device__ __forceinline__ void qkt_sw(f32x16&p0,f32x16&p1,const char*Kslot,const bf16x8*qr,const f32x16&c0,const f32x16&c1,int r32,int hi){
  const int sx=(r32&7)^((r32>>3)&1); const char*kb=Kslot+r32*128;
  #pragma unroll
  for(int d0=0;d0<4;++d0){ const int off=((2*d0+hi)^sx)<<4;
    const bf16x8 b0=*reinterpret_cast<const bf16x8*>(kb+off);
    const bf16x8 b1=*reinterpret_cast<const bf16x8*>(kb+4096+off);
    if(d0==0){p0=__builtin_amdgcn_mfma_f32_32x32x16_bf16(b0,qr[0],c0,0,0,0);p1=__builtin_amdgcn_mfma_f32_32x32x16_bf16(b1,qr[0],c1,0,0,0);}
    else{p0=__builtin_amdgcn_mfma_f32_32x32x16_bf16(b0,qr[d0],p0,0,0,0);p1=__builtin_amdgcn_mfma_f32_32x32x16_bf16(b1,qr[d0],p1,0,0,0);}}
}
typedef __attribute__((address_space(3))) const char* lds_cptr;
typedef short v4i16_t __attribute__((ext_vector_type(4)));
typedef float f32x4_t __attribute__((ext_vector_type(4)));
__device__ __forceinline__ void kload2s(bf16x8*kf,lds_cptr kp,int t6,int j){ const lds_cptr q=kp+((32*j)^t6); kf[2*j]=*(const __attribute__((address_space(3))) bf16x8*)(q); kf[2*j+1]=*(const __attribute__((address_space(3))) bf16x8*)(q+4096); }
__device__ __forceinline__ void kload8s(bf16x8*kf,lds_cptr kp,int t6){ kload2s(kf,kp,t6,0); kload2s(kf,kp,t6,1); kload2s(kf,kp,t6,2); kload2s(kf,kp,t6,3); }
__device__ __forceinline__ void kload8(bf16x8*kf,lds_cptr kp){
  kf[0]=*(const __attribute__((address_space(3))) bf16x8*)(kp);      kf[1]=*(const __attribute__((address_space(3))) bf16x8*)(kp+512);
  kf[2]=*(const __attribute__((address_space(3))) bf16x8*)(kp+2048); kf[3]=*(const __attribute__((address_space(3))) bf16x8*)(kp+2560);
  kf[4]=*(const __attribute__((address_space(3))) bf16x8*)(kp+4096); kf[5]=*(const __attribute__((address_space(3))) bf16x8*)(kp+4608);
  kf[6]=*(const __attribute__((address_space(3))) bf16x8*)(kp+6144); kf[7]=*(const __attribute__((address_space(3))) bf16x8*)(kp+6656);
}
__device__ __forceinline__ void kload2(bf16x8*kf,lds_cptr kp,int j){ kf[2*j]=*(const __attribute__((address_space(3))) bf16x8*)(kp+j*2048); kf[2*j+1]=*(const __attribute__((address_space(3))) bf16x8*)(kp+j*2048+512); }
__device__ __forceinline__ s16x4 vtr(lds_cptr p){ return __builtin_bit_cast(s16x4,__builtin_amdgcn_ds_read_tr16_b64_v4i16((__attribute__((address_space(3))) v4i16_t*)p)); }
__device__ __forceinline__ float rowmax(const f32x16&p0,const f32x16&p1){
  float a=max3f(p0[0],p0[1],p1[0]),b=max3f(p0[2],p0[3],p1[1]);a=max3f(a,p1[2],p1[3]);
  #pragma unroll
  for(int r=4;r<16;r+=4){a=max3f(a,p0[r],p0[r+1]);b=max3f(b,p0[r+2],p0[r+3]);a=max3f(a,p1[r],p1[r+1]);b=max3f(b,p1[r+2],p1[r+3]);}
  const float m=max2f(a,b);
  auto rr=__builtin_amdgcn_permlane32_swap(__float_as_uint(m),__float_as_uint(m),false,false);
  return max2f(__uint_as_float(rr[0]),__uint_as_float(rr[1]));
}
__device__ __forceinline__ void pv(f32x16*o,int vb,bf16x8 pa0,bf16x8 pa1,bf16x8 pa2,bf16x8 pa3){
  #pragma unroll
  for(int d0=0;d0<2;++d0){s16x4 lo[4],hi[4];
    #pragma unroll
    for(int ks=0;ks<4;++ks){
      asm volatile("ds_read_b64_tr_b16 %0,%1 offset:%c2":"=&v"(lo[ks]):"v"(vb),"i"(d0*4096+ks*1024):"memory");
      asm volatile("ds_read_b64_tr_b16 %0,%1 offset:%c2":"=&v"(hi[ks]):"v"(vb),"i"(d0*4096+ks*1024+512):"memory");}
    asm volatile("s_waitcnt lgkmcnt(0)":::"memory");SBAR();
    #define PK(k) (bf16x8){lo[k][0],lo[k][1],lo[k][2],lo[k][3],hi[k][0],hi[k][1],hi[k][2],hi[k][3]}
    o[d0]=__builtin_amdgcn_mfma_f32_32x32x16_bf16(pa0,PK(0),o[d0],0,0,0);
    o[d0]=__builtin_amdgcn_mfma_f32_32x32x16_bf16(pa1,PK(1),o[d0],0,0,0);
    o[d0]=__builtin_amdgcn_mfma_f32_32x32x16_bf16(pa2,PK(2),o[d0],0,0,0);
    o[d0]=__builtin_amdgcn_mfma_f32_32x32x16_bf16(pa3,PK(3),o[d0],0,0,0);
    #undef PK
  }
}
__device__ __forceinline__ void add_bias(f32x16&p0,f32x16&p1,const __attribute__((address_space(3))) float*bp,int hi){
  #pragma unroll
  for(int g=0;g<4;++g){ const f32x4_t b0=*(const __attribute__((address_space(3))) f32x4_t*)(bp+8*g+4*hi), b1=*(const __attribute__((address_space(3))) f32x4_t*)(bp+32+8*g+4*hi);
    #pragma unroll
    for(int j=0;j<4;++j){ p0[4*g+j]+=b0[j]; p1[4*g+j]+=b1[j]; } }
}

struct UnitP {
  const bf16*Qh; const bf16*Kh; const bf16*Vh;
  bf16*Oh; int opitch;
  int rs;
  int q0;
  int t0, NT;
  const bf16*bias;
  const float*kmp; int own;
  float*lse; int lsep;
  const unsigned short*list; int cnt, e0;
  unsigned*glcnt; unsigned short*glist;
  bf16*PO; float*PL; int rowbase6;
};

template<int MODE,int THRL> __device__ __forceinline__ void attn_unit(const UnitP&U,char*shm){
  int tid_=threadIdx.x; asm volatile("":"+v"(tid_));
  const int tid=tid_,lane=tid&63,r32=lane&31,hi=lane>>5; const int wid=__builtin_amdgcn_readfirstlane(tid>>6);
  const int q0=U.q0; const long rsp=(long)U.rs*DMQ;
  const bf16*Qw=U.Qh+(long)(q0+wid*QBLK)*rsp;
  const unsigned lds0=(unsigned)(uintptr_t)shm;
  float*wsf=(float*)(shm+LDS_WS)+wid*64;
  __attribute__((address_space(3))) int*tab=(__attribute__((address_space(3))) int*)(shm+LDS_TAB);
  int NT=U.NT; unsigned selmask=0xffffffffu; unsigned uall=0u;
  struct Cur { unsigned rem; int blk, sub; };
  auto cur_init=[&](Cur&c){ c.rem=uall; c.blk=U.own; c.sub=0; };
  auto cur_next=[&](Cur&c)->int{ const int row=c.blk*256+c.sub*64; if(++c.sub==4){ c.sub=0; if(c.rem){c.blk=__builtin_ctz(c.rem);c.rem&=c.rem-1u;} else c.blk=U.own; } return row; };
  Cur ck,cv,cs;
  const bf16*ksrc=U.Kh+(long)(8*wid+(lane>>3))*rsp+ksw_src_chunk(lane,wid)*8;
  const bf16*vsrc=U.Vh+(long)(16*(wid&3)+(lane>>2))*rsp+(wid>>2)*32+(lane&3)*8;
  const bf16*bsrc=(MODE==0)?(U.bias+lane*8):nullptr;
  const unsigned kdst=lds0+LDS_K+wid*1024, vdst=lds0+LDS_V+wid*1024, bdst=lds0+LDS_BIAS;
  constexpr int NDK=(MODE==0)?2:1;
  #define DMA_K(t,slot) do{ int tr_; if constexpr(MODE==1) tr_=cur_next(ck); else if constexpr(MODE==0) tr_=(U.t0+NT-1-(t))*64; else tr_=(U.t0+(t))*64; glds16(ksrc+(long)tr_*rsp,(unsigned)__builtin_amdgcn_readfirstlane(kdst+(slot))); \
      if constexpr(MODE==0) glds16(bsrc+(long)tr_*8,(unsigned)__builtin_amdgcn_readfirstlane(bdst+((slot)>>3))); }while(0)
  #define DMA_V(t,slot) do{ int tr_; if constexpr(MODE==1) tr_=cur_next(cv); else if constexpr(MODE==0) tr_=(U.t0+NT-1-(t))*64; else tr_=(U.t0+(t))*64; glds16(vsrc+(long)tr_*rsp,(unsigned)__builtin_amdgcn_readfirstlane(vdst+(slot))); }while(0)
  const char*Kbase=shm+LDS_K; bf16x8 kf[8]; bf16x8 kb0,kb1;
  const lds_cptr shm3=(lds_cptr)shm; const int ksx_=(r32&7)^((r32>>3)&1); const lds_cptr kp0=shm3+LDS_K+r32*128+(((hi^ksx_)&1)<<4); const int kt6=(ksx_&6)<<4; const lds_cptr vp0=shm3+LDS_V+((lane>>4)&1)*32+(lane&3)*8+(4*hi+((lane&15)>>2))*64;
  const lds_cptr bp0=shm3+LDS_BIAS+r32*16;
  u32x4 qaw; qaw.x=(hi==0)?0x3f803f80u:0u; qaw.y=(hi==0)?0x00003f80u:0u; qaw.z=0u; qaw.w=0u; const bf16x8 qaug=__builtin_bit_cast(bf16x8,qaw);
  if constexpr(MODE==1){ cur_init(ck); cur_init(cv); cur_init(cs); }
  DMA_K(0,0);DMA_V(0,0);DMA_K(1,SLOTB);
  bf16x8 qr[4];
  if constexpr(MODE==4){
    const int e=U.e0+wid*QBLK+r32; const bool valid=e<U.cnt; const unsigned ent=*(const __attribute__((address_space(1))) unsigned short*)(U.list+(valid?e:U.cnt-1));
    const int tq=(int)(ent&8191u), slot=(int)(ent>>13);
    if(hi==0)tab[128+wid*QBLK+r32]=valid?((U.rowbase6+tq*6)*3+slot):-1;
    const bf16*Qg=U.Qh+(long)tq*DMQ;
    #pragma unroll
    for(int d0=0;d0<4;++d0)qr[d0]=*(const __attribute__((address_space(1))) bf16x8*)(&Qg[d0*16+hi*8]);
  } else {
  #pragma unroll
  for(int d0=0;d0<4;++d0){ if constexpr(MODE==0) qr[d0]=__builtin_nontemporal_load((const __attribute__((address_space(1))) bf16x8*)(&Qw[(long)r32*rsp+d0*16+hi*8])); else qr[d0]=*(const __attribute__((address_space(1))) bf16x8*)(&Qw[(long)r32*rsp+d0*16+hi*8]); }
  }
  if constexpr(MODE==1||MODE==6){
    f32x16 g=f32x16{};
    #pragma unroll
    for(int d0=0;d0<4;++d0){ const float*kp=U.kmp+(long)r32*2048+d0*16+hi*8;
      typedef const __attribute__((address_space(1))) f32x4_t* gp4; const f32x4_t a0=*(gp4)kp,a1=*(gp4)(kp+4),b0=*(gp4)(kp+1024),b1=*(gp4)(kp+1028);
      const f32x4_t s0=a0+b0,s1=a1+b1; u32x4 w; w.x=cvtpk_s(s0[0],s0[1]);w.y=cvtpk_s(s0[2],s0[3]);w.z=cvtpk_s(s1[0],s1[1]);w.w=cvtpk_s(s1[2],s1[3]);
      g=__builtin_amdgcn_mfma_f32_32x32x16_bf16(__builtin_bit_cast(bf16x8,w),qr[d0],g,0,0,0); }
    #pragma unroll
    for(int r=0;r<16;++r) if(crow(r,hi)>=U.own) g[r]=-INFINITY;
    unsigned bits=0u;
    #pragma unroll
    for(int k=0;k<3;++k){
      float m=g[0];
      #pragma unroll
      for(int r=1;r<16;++r)m=__builtin_fmaxf(m,g[r]);
      auto rr=__builtin_amdgcn_permlane32_swap(__float_as_uint(m),__float_as_uint(m),false,false);
      const float mo=(hi==0)?__uint_as_float(rr[1]):__uint_as_float(rr[0]);
      const float gm=__builtin_fmaxf(m,mo);
      const bool mine=(m==gm)&&(gm>-INFINITY)&&!(hi==1&&mo==gm);
      bool found=!mine;
      #pragma unroll
      for(int r=0;r<16;++r){ const bool hit=(!found)&&(g[r]==gm); if(hit){g[r]=-INFINITY;bits|=(1u<<crow(r,hi));} found=found||hit; }
    }
    { auto rr=__builtin_amdgcn_permlane32_swap(bits,bits,false,false); bits=rr[0]|rr[1]; }
    if constexpr(MODE==6){
      if(tid<64)tab[tid]=0;
      asm volatile("s_waitcnt lgkmcnt(0)\n\ts_barrier":::"memory");
      int n0=-1,n1=-1,n2=-1,k0=0,k1=0,k2=0;
      if(hi==0){ unsigned bb=bits;
        if(bb){n0=__builtin_ctz(bb);bb&=bb-1u;k0=__hip_atomic_fetch_add(&tab[n0],1,__ATOMIC_RELAXED,__HIP_MEMORY_SCOPE_WORKGROUP);}
        if(bb){n1=__builtin_ctz(bb);bb&=bb-1u;k1=__hip_atomic_fetch_add(&tab[n1],1,__ATOMIC_RELAXED,__HIP_MEMORY_SCOPE_WORKGROUP);}
        if(bb){n2=__builtin_ctz(bb);k2=__hip_atomic_fetch_add(&tab[n2],1,__ATOMIC_RELAXED,__HIP_MEMORY_SCOPE_WORKGROUP);} }
      asm volatile("s_waitcnt lgkmcnt(0)\n\ts_barrier":::"memory");
      if(tid<32){ const int c=tab[tid]; if(c>0)tab[32+tid]=(int)__hip_atomic_fetch_add(U.glcnt+tid,(unsigned)c,__ATOMIC_RELAXED,__HIP_MEMORY_SCOPE_AGENT); }
      asm volatile("s_waitcnt vmcnt(0) lgkmcnt(0)\n\ts_barrier":::"memory");
      if(hi==0){ const unsigned tq=(unsigned)(q0+wid*QBLK+r32); __attribute__((address_space(1))) unsigned short*L=(__attribute__((address_space(1))) unsigned short*)U.glist;
        if(n0>=0)L[(long)n0*8192+tab[32+n0]+k0]=(unsigned short)(tq);
        if(n1>=0)L[(long)n1*8192+tab[32+n1]+k1]=(unsigned short)(tq|(1u<<13));
        if(n2>=0)L[(long)n2*8192+tab[32+n2]+k2]=(unsigned short)(tq|(2u<<13)); }
    } else {
    selmask=bits|(1u<<U.own);
    unsigned un=bits;
    #pragma unroll
    for(int o=1;o<32;o<<=1)un|=(unsigned)__shfl_xor((int)un,o);
    if(lane==0)tab[64+wid]=(int)un;
    asm volatile("s_waitcnt lgkmcnt(0)\n\ts_barrier":::"memory");
    #pragma unroll
    for(int w=0;w<8;++w)uall|=(unsigned)tab[64+w];
    uall=(unsigned)__builtin_amdgcn_readfirstlane((int)uall);
    NT=4*__builtin_popcount(uall)+4;
    }
  }
  if constexpr(MODE==1){ ck.rem=uall; cv.rem=uall; cs.rem=uall; }
  float mhat=0.f,l_reg=0.f;f32x16 o[2];o[0]=f32x16{};o[1]=f32x16{};f32x16 negm=f32x16{};
  #define NEGSEL() do{ if constexpr(MODE==1){ const int blk_=cs.blk; (void)cur_next(cs); const float nm_=((selmask>>blk_)&1u)?-mhat:-1e30f; _Pragma("unroll") for(int r=0;r<16;++r)negm[r]=nm_; asm volatile("":"+v"(negm)); } }while(0)
  NEGSEL();
  asm volatile("":"+v"(negm));
  const int qrel=wid*QBLK+r32;
  #define CMASK(P0,P1,t) do{ if constexpr(MODE==4){} else if constexpr(MODE==2){ wmask(P0,P1,(U.t0+(t))*64-q0,qrel,hi); } else if constexpr(MODE==1){ if((t)<4)cmask(P0,P1,(t),qrel,hi); } else if constexpr(MODE==0){ if((t)<4)cmask(P0,P1,3-(t),qrel,hi); } else { int jb_=(t)-(NT-4); if(jb_>=0)cmask(P0,P1,jb_,qrel,hi); } }while(0)
  bool resc=false;
  #define START(P0,P1) do{ const float rm=rowmax(P0,P1); resc=false; \
    { const float dl=__builtin_fmaxf(rm,-1000.f); mhat=fadd_s(mhat,dl); \
      _Pragma("unroll") for(int r=0;r<16;++r){P0[r]=fsub_s(P0[r],dl);P1[r]=fsub_s(P1[r],dl);} \
      _Pragma("unroll") for(int r=0;r<16;++r)negm[r]=-mhat; asm volatile("":"+v"(negm)); } \
    _Pragma("unroll") for(int r=0;r<16;++r)P0[r]=__builtin_amdgcn_exp2f(P0[r]); }while(0)
  #define RESC() do{ if(resc){ asm volatile("s_waitcnt lgkmcnt(0)":::"memory"); \
      _Pragma("unroll") for(int d_=0;d_<2;++d_) _Pragma("unroll") for(int r=0;r<16;++r)o[d_][r]*=wsf[crow(r,hi)]; } }while(0)
  f32x16 pA0,pA1,pB0,pB1;
  int sl_prev=0,sl_cur=0,sl_next=SLOTB;
  #define ROT() do{sl_prev=sl_cur;sl_cur=sl_next;sl_next=(sl_next==(NSLOT-1)*SLOTB)?0:sl_next+SLOTB;}while(0)
  DMA_K(2,2*SLOTB);
  WAIT_BAR(2*NDK+1);
  if constexpr(MODE==0){ const bf16x8 b0=*(const __attribute__((address_space(3))) bf16x8*)(bp0), b1=*(const __attribute__((address_space(3))) bf16x8*)(bp0+512);
    pA0=__builtin_amdgcn_mfma_f32_32x32x16_bf16(b0,qaug,negm,0,0,0); pA1=__builtin_amdgcn_mfma_f32_32x32x16_bf16(b1,qaug,negm,0,0,0); qkt_sw(pA0,pA1,Kbase,qr,pA0,pA1,r32,hi); }
  else qkt_sw(pA0,pA1,Kbase,qr,negm,negm,r32,hi);
  asm volatile("s_nop 15\n\ts_nop 7":"+v"(pA0),"+v"(pA1));CMASK(pA0,pA1,0);
  START(pA0,pA1);
  NEGSEL();
  _Pragma("unroll") for(int r=0;r<16;++r)pA1[r]=__builtin_amdgcn_exp2f(pA1[r]);
  WAIT_BAR(0);
  DMA_K(3,0);DMA_V(1,SLOTB);
  ROT();
  kload8s(kf,kp0+sl_cur,kt6);
  if constexpr(MODE==0){ kb0=*(const __attribute__((address_space(3))) bf16x8*)(bp0+(sl_cur>>3)); kb1=*(const __attribute__((address_space(3))) bf16x8*)(bp0+(sl_cur>>3)+512); }
  WAIT_BAR(NDK+1);
  s16x4 vlo[8],vhi[8]; u32x4 pw0,pw1,pw2,pw3;
  #define PKW(P,B) cvtpk_s(P[B],P[B+1])
  #define PAF(k) __builtin_bit_cast(bf16x8,pw##k)
  #define VFR(i) (bf16x8){vlo[i][0],vlo[i][1],vlo[i][2],vlo[i][3],vhi[i][0],vhi[i][1],vhi[i][2],vhi[i][3]}
  #define PIN(x) asm volatile("":"+v"(x))
  #define MX3(a,b,c) __builtin_fmaxf(__builtin_fmaxf((a),(b)),(c))
  #define GAPA(MF,A0,A1,A2,A3,W0,W1,PW) do{ MF; sacc+=A0; sacc+=A1; sacc+=A2; sacc+=A3; PIN(sacc); W0; W1; PIN(PW); SBAR(); }while(0)
  #define EX(v) __builtin_amdgcn_exp2f(v)
  #define GAPB(MF,X,B) do{ MF; X[B]=EX(X[B]); X[B+1]=EX(X[B+1]); X[B+2]=EX(X[B+2]); X[B+3]=EX(X[B+3]); PIN(X); SBAR(); }while(0)
  #define VRD(i) do{ vlo[i]=vtr(vp_+(((i)>>2)*4096+((i)&3)*1024)); vhi[i]=vtr(vp_+(((i)>>2)*4096+((i)&3)*1024+512)); }while(0)
  #define KRD(G,j) do{ if(G){ kload2s(kf,kp0+sl_next,kt6,j); SBAR(); } }while(0)
  #define KRDB(G) do{ if constexpr(MODE==0){ if(G){ kb0=*(const __attribute__((address_space(3))) bf16x8*)(bp0+(sl_next>>3)); kb1=*(const __attribute__((address_space(3))) bf16x8*)(bp0+(sl_next>>3)+512); SBAR(); } } }while(0)
  #define QK0(C0,C1) do{ if constexpr(MODE==0){ C0=__builtin_amdgcn_mfma_f32_32x32x16_bf16(kb0,qaug,negm,0,0,0); C1=__builtin_amdgcn_mfma_f32_32x32x16_bf16(kb1,qaug,negm,0,0,0); SBAR(); } }while(0)
  #define CIN(C) ((MODE==0)?C:negm)
  #define STEP(C0,C1,P0,P1,t,GK,GV,GL) do{ SBAR(); \
    const lds_cptr vp_=vp0+sl_prev; \
    QK0(C0,C1); \
    VRD(0); SBAR(); float sacc=(P0[0]+P0[1]); \
    GAPA(C0=__builtin_amdgcn_mfma_f32_32x32x16_bf16(kf[0],qr[0],CIN(C0),0,0,0), P0[2],P0[3],P0[4],P0[5],     pw0[0]=PKW(P0,0), pw0[1]=PKW(P0,2), pw0); \
    VRD(4); SBAR(); GAPA(C1=__builtin_amdgcn_mfma_f32_32x32x16_bf16(kf[1],qr[0],CIN(C1),0,0,0), P0[6],P0[7],P0[8],P0[9],     pw0[2]=PKW(P0,4), pw0[3]=PKW(P0,6), pw0); \
    VRD(1); SBAR(); GAPA(C0=__builtin_amdgcn_mfma_f32_32x32x16_bf16(kf[2],qr[1],C0,0,0,0),   P0[10],P0[11],P0[12],P0[13], pw1[0]=PKW(P0,8), pw1[1]=PKW(P0,10), pw1); \
    VRD(5); SBAR(); GAPA(C1=__builtin_amdgcn_mfma_f32_32x32x16_bf16(kf[3],qr[1],C1,0,0,0),   P0[14],P0[15],P1[0],P1[1],   pw1[2]=PKW(P0,12),pw1[3]=PKW(P0,14), pw1); \
    VRD(2); SBAR(); GAPA(C0=__builtin_amdgcn_mfma_f32_32x32x16_bf16(kf[4],qr[2],C0,0,0,0),   P1[2],P1[3],P1[4],P1[5],     pw2[0]=PKW(P1,0), pw2[1]=PKW(P1,2), pw2); \
    VRD(6); SBAR(); GAPA(C1=__builtin_amdgcn_mfma_f32_32x32x16_bf16(kf[5],qr[2],C1,0,0,0),   P1[6],P1[7],P1[8],P1[9],     pw2[2]=PKW(P1,4), pw2[3]=PKW(P1,6), pw2); \
    VRD(3); SBAR(); GAPA(C0=__builtin_amdgcn_mfma_f32_32x32x16_bf16(kf[6],qr[3],C0,0,0,0),   P1[10],P1[11],P1[12],P1[13], pw3[0]=PKW(P1,8), pw3[1]=PKW(P1,10), pw3); \
    VRD(7); SBAR(); GAPA(C1=__builtin_amdgcn_mfma_f32_32x32x16_bf16(kf[7],qr[3],C1,0,0,0),   P1[14],P1[15],0.f,0.f,       pw3[2]=PKW(P1,12),pw3[3]=PKW(P1,14), pw3); \
    l_reg+=sacc; \
    if(GK){DMA_K((t)+3,sl_cur);} if(GV){DMA_V((t)+1,sl_next);} \
    CMASK(C0,C1,t); \
    { float a=MX3(C0[0],C0[1],C1[0]),b=MX3(C0[2],C0[3],C1[1]); a=MX3(a,C1[2],C1[3]); \
      _Pragma("unroll") for(int r=4;r<16;r+=4){a=MX3(a,C0[r],C0[r+1]);b=MX3(b,C0[r+2],C0[r+3]);a=MX3(a,C1[r],C1[r+1]);b=MX3(b,C1[r+2],C1[r+3]);} \
      float rm=__builtin_fmaxf(a,b); { auto rr=__builtin_amdgcn_permlane32_swap(__float_as_uint(rm),__float_as_uint(rm),false,false); rm=__builtin_fmaxf(__uint_as_float(rr[0]),__uint_as_float(rr[1])); } \
      resc=false; \
      if(__builtin_expect(__any(rm>(float)THRL),0)){ const float dl=__builtin_fmaxf(rm,0.f); mhat+=dl; \
        _Pragma("unroll") for(int r=0;r<16;++r){C0[r]-=dl;C1[r]-=dl;} \
        _Pragma("unroll") for(int r=0;r<16;++r)negm[r]=-mhat; asm volatile("":"+v"(negm)); \
        const float f=__builtin_amdgcn_exp2f(-dl); l_reg*=f; if(hi==0)wsf[r32]=f; resc=true; } } \
    SBAR(); \
    GAPB(o[0]=__builtin_amdgcn_mfma_f32_32x32x16_bf16(PAF(0),VFR(0),o[0],0,0,0), C0,0); \
    GAPB(o[1]=__builtin_amdgcn_mfma_f32_32x32x16_bf16(PAF(0),VFR(4),o[1],0,0,0), C0,4); \
    if(GL){NEGSEL(); SBAR();} \
    KRD(GL,0); GAPB(o[0]=__builtin_amdgcn_mfma_f32_32x32x16_bf16(PAF(1),VFR(1),o[0],0,0,0), C0,8); \
    KRD(GL,1); GAPB(o[1]=__builtin_amdgcn_mfma_f32_32x32x16_bf16(PAF(1),VFR(5),o[1],0,0,0), C0,12); \
    KRD(GL,2); GAPB(o[0]=__builtin_amdgcn_mfma_f32_32x32x16_bf16(PAF(2),VFR(2),o[0],0,0,0), C1,0); \
    KRD(GL,3); GAPB(o[1]=__builtin_amdgcn_mfma_f32_32x32x16_bf16(PAF(2),VFR(6),o[1],0,0,0), C1,4); \
    KRDB(GL); GAPB(o[0]=__builtin_amdgcn_mfma_f32_32x32x16_bf16(PAF(3),VFR(3),o[0],0,0,0), C1,8); \
    GAPB(o[1]=__builtin_amdgcn_mfma_f32_32x32x16_bf16(PAF(3),VFR(7),o[1],0,0,0), C1,12); \
    }while(0)
  int t=1;
  if constexpr(MODE!=2){
  #undef CMASK
  #define CMASK(P0,P1,t) do{ if constexpr(MODE==1){ if((t)<4)cmask(P0,P1,(t),qrel,hi); } else if constexpr(MODE==0){ if((t)<4)cmask(P0,P1,3-(t),qrel,hi); } }while(0)
  for(;t+5<NT;t+=2){
    STEP(pB0,pB1,pA0,pA1,t,true,true,true);     WAIT_BAR(NDK+1); RESC(); ROT();
    STEP(pA0,pA1,pB0,pB1,t+1,true,true,true);   WAIT_BAR(NDK+1); RESC(); ROT();
  }
  #undef CMASK
  #define CMASK(P0,P1,t) do{ if constexpr(MODE==4){} else if constexpr(MODE==2){ wmask(P0,P1,(U.t0+(t))*64-q0,qrel,hi); } else if constexpr(MODE==1){ if((t)<4)cmask(P0,P1,(t),qrel,hi); } else if constexpr(MODE==0){ if((t)<4)cmask(P0,P1,3-(t),qrel,hi); } else { int jb_=(t)-(NT-4); if(jb_>=0)cmask(P0,P1,jb_,qrel,hi); } }while(0)
  }
  #define ENDW(tt) do{ if((tt)+3<NT){WAIT_BAR(NDK+1);} else if((tt)+2<NT){WAIT_BAR(1);} else {WAIT_BAR(0);} }while(0)
  for(;t+1<NT;t+=2){
    STEP(pB0,pB1,pA0,pA1,t,(t+3<NT),(t+1<NT),(t+1<NT));       ENDW(t);   RESC(); ROT();
    STEP(pA0,pA1,pB0,pB1,t+1,(t+4<NT),(t+2<NT),(t+2<NT));     ENDW(t+1); RESC(); ROT();
  }
  STEP(pB0,pB1,pA0,pA1,NT-1,false,false,false); RESC();
  { float sacc=pB0[0]+pB0[1]; _Pragma("unroll") for(int r=2;r<16;++r)sacc+=pB0[r]; _Pragma("unroll") for(int r=0;r<16;++r)sacc+=pB1[r]; l_reg+=sacc;
    pw0=(u32x4){PKW(pB0,0),PKW(pB0,2),PKW(pB0,4),PKW(pB0,6)};pw1=(u32x4){PKW(pB0,8),PKW(pB0,10),PKW(pB0,12),PKW(pB0,14)};pw2=(u32x4){PKW(pB1,0),PKW(pB1,2),PKW(pB1,4),PKW(pB1,6)};pw3=(u32x4){PKW(pB1,8),PKW(pB1,10),PKW(pB1,12),PKW(pB1,14)};
    int t2_=threadIdx.x; asm volatile("":"+v"(t2_)); const int l2_=t2_&63,h2_=l2_>>5;
    const int vb0=(int)(lds0+LDS_V)+((l2_>>4)&1)*32+(l2_&3)*8+(4*h2_+((l2_&15)>>2))*64;
    SBAR(); pv(o,vb0+sl_cur,PAF(0),PAF(1),PAF(2),PAF(3)); }
  #undef PKW
  #undef PAF
  #undef VFR
  #undef PIN
  #undef MX3
  #undef GAPA
  #undef GAPB
  #undef EX
  #undef VRD
  #undef KRD
  #undef KRDB
  #undef QK0
  #undef CIN
  #undef STEP
  #undef ENDW
  { int t3_=threadIdx.x; asm volatile("":"+v"(t3_)); const int lane3=t3_&63,r3=lane3&31,h3=lane3>>5,qrel3=wid*QBLK+r3;
  {auto rr=__builtin_amdgcn_permlane32_swap(__float_as_uint(l_reg),__float_as_uint(l_reg),false,false);l_reg=__uint_as_float(rr[0])+__uint_as_float(rr[1]);}
  if(h3==0)wsf[32+r3]=l_reg;asm volatile("s_waitcnt lgkmcnt(0)":::"memory");
  if constexpr(MODE==2||MODE==5||MODE==6){ if(h3==0)*(__attribute__((address_space(1))) float*)(U.lse+(long)(q0+qrel3)*U.rs*U.lsep)=mhat+__builtin_amdgcn_logf(l_reg); }
  if constexpr(MODE==4){ const int d_=tab[128+wid*QBLK+r3]; if(h3==0&&d_>=0)*(__attribute__((address_space(1))) float*)(U.PL+(long)(d_/3)*4+(d_%3))=mhat+__builtin_amdgcn_logf(l_reg); }
  float rli[16];
  #pragma unroll
  for(int r=0;r<16;++r)rli[r]=__builtin_amdgcn_rcpf(wsf[32+crow(r,h3)]);
  bf16*Ow=U.Oh+(long)(q0+wid*QBLK)*U.rs*U.opitch;
  { bf16*stg=(bf16*)(shm+LDS_OST)+wid*2048;
    #pragma unroll
    for(int r=0;r<16;++r){const int orow=crow(r,h3);
      #pragma unroll
      for(int d0=0;d0<2;++d0)stg[orow*64+d0*32+r3]=(bf16)(cvtpk_s(o[d0][r]*rli[r],0.f)&0xffffu);}
    asm volatile("s_waitcnt lgkmcnt(0)":::"memory");
    #pragma unroll
    for(int i=0;i<4;++i){const int row=i*8+(lane3>>3),ch=lane3&7; const u32x4 v=*(const u32x4*)(stg+row*64+ch*8);
      if constexpr(MODE==4){ const int d_=tab[128+wid*QBLK+row]; if(d_>=0)*(__attribute__((address_space(1))) u32x4*)(U.PO+(long)d_*64+ch*8)=v; }
      else *(__attribute__((address_space(1))) u32x4*)(Ow+(long)row*U.rs*U.opitch+ch*8)=v;} } }
  asm volatile("s_waitcnt lgkmcnt(0)\n\ts_barrier":::"memory");
  #undef DMA_K
  #undef DMA_V
  #undef CMASK
  #undef NEGSEL
  #undef START
  #undef RESC
  #undef ROT
}
constexpr int RS_K=0, RS_V=4*SLOTB, RS_WS=8*SLOTB, RS_OST=RS_WS+NW*256, RS_BYTES=RS_OST+NW*4096;
template<int THRL> __device__ __forceinline__ void routed_stat_unit(const bf16*Qh,const bf16*Kh,const bf16*Vh,const unsigned short*list,int e0,int e1,int n,bf16*PO,float*PL,int rowbase6,char*shm){
  int tid_=threadIdx.x; asm volatile("":"+v"(tid_));
  const int tid=tid_,lane=tid&63,r32=lane&31,hi=lane>>5; const int wid=__builtin_amdgcn_readfirstlane(tid>>6);
  const unsigned lds0=(unsigned)(uintptr_t)shm;
  { const bf16*ksrc=Kh+(long)(n*256+8*wid+(lane>>3))*DMQ+ksw_src_chunk(lane,wid)*8; const bf16*vsrc=Vh+(long)(n*256+16*(wid&3)+(lane>>2))*DMQ+(wid>>2)*32+(lane&3)*8;
    #pragma unroll
    for(int t=0;t<4;++t){ glds16(ksrc+(long)t*64*DMQ,(unsigned)__builtin_amdgcn_readfirstlane(lds0+RS_K+t*SLOTB+wid*1024)); glds16(vsrc+(long)t*64*DMQ,(unsigned)__builtin_amdgcn_readfirstlane(lds0+RS_V+t*SLOTB+wid*1024)); }
    asm volatile("s_waitcnt vmcnt(0)\n\ts_barrier":::"memory"); }
  float*wsf=(float*)(shm+RS_WS)+wid*64;
  const lds_cptr vp0s=(lds_cptr)shm+RS_V+((lane>>4)&1)*32+(lane&3)*8+(4*hi+((lane&15)>>2))*64;
  const int ng=(e1-e0+31)>>5;
  typedef const __attribute__((address_space(1))) unsigned short* gu16p; typedef const __attribute__((address_space(1))) bf16x8* gq8p;
  int g=wid; unsigned ent=0u; bf16x8 qr[4];
  if(g<ng){ const int e=e0+g*32+r32; ent=*(gu16p)(list+(e<e1?e:e1-1));
    const bf16*Qg=Qh+(long)(ent&8191u)*DMQ;
    #pragma unroll
    for(int d0=0;d0<4;++d0)qr[d0]=*(gq8p)(Qg+d0*16+hi*8); }
  for(;g<ng;g+=NW){
    const int e=e0+g*32+r32; const bool valid=e<e1; const int dst=valid?((rowbase6+(int)(ent&8191u)*6)*3+(int)(ent>>13)):-1;
    const int gn=g+NW; unsigned entn=0u; if(gn<ng){ const int en=e0+gn*32+r32; entn=*(gu16p)(list+(en<e1?en:e1-1)); }
    bf16x8 qn[4];
    float mhat=0.f,l_reg=0.f; f32x16 o[2]; o[0]=f32x16{}; o[1]=f32x16{}; f32x16 negm=f32x16{};
    f32x16 pc0,pc1,pn0,pn1; qkt_sw(pc0,pc1,shm+RS_K,qr,negm,negm,r32,hi);
    #pragma unroll
    for(int t=0;t<4;++t){
      if(t<3) qkt_sw(pn0,pn1,shm+RS_K+(t+1)*SLOTB,qr,negm,negm,r32,hi);
      f32x16&p0=pc0; f32x16&p1=pc1;
      float a=__builtin_fmaxf(__builtin_fmaxf(p0[0],p0[1]),p1[0]),b=__builtin_fmaxf(__builtin_fmaxf(p0[2],p0[3]),p1[1]); a=__builtin_fmaxf(__builtin_fmaxf(a,p1[2]),p1[3]);
      #pragma unroll
      for(int r=4;r<16;r+=4){a=__builtin_fmaxf(__builtin_fmaxf(a,p0[r]),p0[r+1]);b=__builtin_fmaxf(__builtin_fmaxf(b,p0[r+2]),p0[r+3]);a=__builtin_fmaxf(__builtin_fmaxf(a,p1[r]),p1[r+1]);b=__builtin_fmaxf(__builtin_fmaxf(b,p1[r+2]),p1[r+3]);}
      float rm=__builtin_fmaxf(a,b); { auto rr=__builtin_amdgcn_permlane32_swap(__float_as_uint(rm),__float_as_uint(rm),false,false); rm=__builtin_fmaxf(__uint_as_float(rr[0]),__uint_as_float(rr[1])); }
      if(t==0){ const float dl=rm; mhat=dl;
        #pragma unroll
        for(int r=0;r<16;++r){p0[r]-=dl;p1[r]-=dl;pn0[r]-=dl;pn1[r]-=dl;}
        #pragma unroll
        for(int r=0;r<16;++r)negm[r]=-mhat; }
      else if(__builtin_expect(__any(rm>(float)THRL),0)){ const float dl=__builtin_fmaxf(rm,0.f); mhat+=dl;
        #pragma unroll
        for(int r=0;r<16;++r){p0[r]-=dl;p1[r]-=dl;}
        if(t<3){
          #pragma unroll
          for(int r=0;r<16;++r){pn0[r]-=dl;pn1[r]-=dl;} }
        #pragma unroll
        for(int r=0;r<16;++r)negm[r]=-mhat;
        const float f=__builtin_amdgcn_exp2f(-dl); l_reg*=f; if(hi==0)wsf[r32]=f;
        #pragma unroll
        for(int d_=0;d_<2;++d_)
          #pragma unroll
          for(int r=0;r<16;++r)o[d_][r]*=wsf[crow(r,hi)]; }
      s16x4 vlo[8],vhi[8]; { const lds_cptr vp_=vp0s+t*SLOTB;
        #pragma unroll
        for(int i=0;i<8;++i){ vlo[i]=vtr(vp_+((i>>2)*4096+(i&3)*1024)); vhi[i]=vtr(vp_+((i>>2)*4096+(i&3)*1024+512)); } }
      #pragma unroll
      for(int r=0;r<16;++r){p0[r]=__builtin_amdgcn_exp2f(p0[r]);p1[r]=__builtin_amdgcn_exp2f(p1[r]);}
      float sacc=0.f;
      #pragma unroll
      for(int r=0;r<16;++r)sacc+=p0[r]+p1[r];
      l_reg+=sacc;
      u32x4 pw0=(u32x4){cvtpk_s(p0[0],p0[1]),cvtpk_s(p0[2],p0[3]),cvtpk_s(p0[4],p0[5]),cvtpk_s(p0[6],p0[7])},pw1=(u32x4){cvtpk_s(p0[8],p0[9]),cvtpk_s(p0[10],p0[11]),cvtpk_s(p0[12],p0[13]),cvtpk_s(p0[14],p0[15])},
            pw2=(u32x4){cvtpk_s(p1[0],p1[1]),cvtpk_s(p1[2],p1[3]),cvtpk_s(p1[4],p1[5]),cvtpk_s(p1[6],p1[7])},pw3=(u32x4){cvtpk_s(p1[8],p1[9]),cvtpk_s(p1[10],p1[11]),cvtpk_s(p1[12],p1[13]),cvtpk_s(p1[14],p1[15])};
      #define VFRS(i) (bf16x8){vlo[i][0],vlo[i][1],vlo[i][2],vlo[i][3],vhi[i][0],vhi[i][1],vhi[i][2],vhi[i][3]}
      o[0]=__builtin_amdgcn_mfma_f32_32x32x16_bf16(__builtin_bit_cast(bf16x8,pw0),VFRS(0),o[0],0,0,0); o[1]=__builtin_amdgcn_mfma_f32_32x32x16_bf16(__builtin_bit_cast(bf16x8,pw0),VFRS(4),o[1],0,0,0);
      o[0]=__builtin_amdgcn_mfma_f32_32x32x16_bf16(__builtin_bit_cast(bf16x8,pw1),VFRS(1),o[0],0,0,0); o[1]=__builtin_amdgcn_mfma_f32_32x32x16_bf16(__builtin_bit_cast(bf16x8,pw1),VFRS(5),o[1],0,0,0);
      o[0]=__builtin_amdgcn_mfma_f32_32x32x16_bf16(__builtin_bit_cast(bf16x8,pw2),VFRS(2),o[0],0,0,0); o[1]=__builtin_amdgcn_mfma_f32_32x32x16_bf16(__builtin_bit_cast(bf16x8,pw2),VFRS(6),o[1],0,0,0);
      o[0]=__builtin_amdgcn_mfma_f32_32x32x16_bf16(__builtin_bit_cast(bf16x8,pw3),VFRS(3),o[0],0,0,0); o[1]=__builtin_amdgcn_mfma_f32_32x32x16_bf16(__builtin_bit_cast(bf16x8,pw3),VFRS(7),o[1],0,0,0);
      #undef VFRS
      if(t==0&&gn<ng){ const bf16*Qg=Qh+(long)(entn&8191u)*DMQ;
        #pragma unroll
        for(int d0=0;d0<4;++d0)qn[d0]=*(gq8p)(Qg+d0*16+hi*8); }
      if(t<3){ pc0=pn0; pc1=pn1; }
    }
    {auto rr=__builtin_amdgcn_permlane32_swap(__float_as_uint(l_reg),__float_as_uint(l_reg),false,false);l_reg=__uint_as_float(rr[0])+__uint_as_float(rr[1]);}
    if(hi==0){ wsf[32+r32]=l_reg; if(dst>=0)*(__attribute__((address_space(1))) float*)(PL+(long)(dst/3)*4+(dst%3))=mhat+__builtin_amdgcn_logf(l_reg); }
    float rli[16];
    #pragma unroll
    for(int r=0;r<16;++r)rli[r]=__builtin_amdgcn_rcpf(wsf[32+crow(r,hi)]);
    { bf16*stg=(bf16*)(shm+RS_OST)+wid*2048;
      #pragma unroll
      for(int r=0;r<16;++r){const int orow=crow(r,hi);
        #pragma unroll
        for(int d0=0;d0<2;++d0)stg[orow*64+d0*32+r32]=(bf16)(cvtpk_s(o[d0][r]*rli[r],0.f)&0xffffu);}
      #pragma unroll
      for(int i=0;i<4;++i){const int row=i*8+(lane>>3),ch=lane&7; const u32x4 v=*(const u32x4*)(stg+row*64+ch*8); const int dr=__shfl(dst,row);
        if(dr>=0)*(__attribute__((address_space(1))) u32x4*)(PO+(long)dr*64+ch*8)=v;} }
    if(gn<ng){
      #pragma unroll
      for(int d0=0;d0<4;++d0)qr[d0]=qn[d0]; }
    ent=entn;
  }
  asm volatile("s_waitcnt lgkmcnt(0)\n\ts_barrier":::"memory");
}

constexpr int DS_K=0, DS_V=6*SLOTB, DS_WS=12*SLOTB, DS_OST=DS_WS+NW*256, DS_BYTES=DS_OST+NW*4096;
template<int THRL> __device__ __forceinline__ void dil_stat_unit(const bf16*Qh,const bf16*Kh,const bf16*Vh,int rs,int sb,bf16*Oh,int opitch,float*lse,int lsep,char*shm){
  int tid_=threadIdx.x; asm volatile("":"+v"(tid_));
  const int tid=tid_,lane=tid&63,r32=lane&31,hi=lane>>5; const int wid=__builtin_amdgcn_readfirstlane(tid>>6);
  const unsigned lds0=(unsigned)(uintptr_t)shm; const long rsp=(long)rs*DMQ;
  const int T0=sb>0?4*sb-2:0, NTL=4*sb+4-T0;
  { const bf16*ksrc=Kh+(long)(T0*64+8*wid+(lane>>3))*rsp+ksw_src_chunk(lane,wid)*8; const bf16*vsrc=Vh+(long)(T0*64+16*(wid&3)+(lane>>2))*rsp+(wid>>2)*32+(lane&3)*8;
    #pragma unroll 1
    for(int t=0;t<NTL;++t){ glds16(ksrc+(long)t*64*rsp,(unsigned)__builtin_amdgcn_readfirstlane(lds0+DS_K+t*SLOTB+wid*1024)); glds16(vsrc+(long)t*64*rsp,(unsigned)__builtin_amdgcn_readfirstlane(lds0+DS_V+t*SLOTB+wid*1024)); } }
  typedef const __attribute__((address_space(1))) bf16x8* gq8p;
  const int i0=sb*256+wid*QBLK;
  bf16x8 qr[4];
  { const bf16*Qg=Qh+(long)(i0+r32)*rsp;
    #pragma unroll
    for(int d0=0;d0<4;++d0)qr[d0]=__builtin_nontemporal_load((gq8p)(Qg+d0*16+hi*8)); }
  asm volatile("s_waitcnt vmcnt(0)\n\ts_barrier":::"memory");
  float*wsf=(float*)(shm+DS_WS)+wid*64;
  const int tf=(i0>128?i0-128:0)>>6, tl=(i0+31)>>6, nt=tl-tf+1, s0=tf-T0;
  const lds_cptr vp0s=(lds_cptr)shm+DS_V+s0*SLOTB+((lane>>4)&1)*32+(lane&3)*8+(4*hi+((lane&15)>>2))*64;
  const char*kb0=shm+DS_K+s0*SLOTB;
  const int qrel=wid*QBLK+r32, kbr0=tf*64-sb*256;
  float mhat=0.f,l_reg=0.f; f32x16 o[2]; o[0]=f32x16{}; o[1]=f32x16{}; f32x16 negm=f32x16{};
  f32x16 pc0,pc1,pn0=f32x16{},pn1=f32x16{}; qkt_sw(pc0,pc1,kb0,qr,negm,negm,r32,hi);
  #pragma unroll
  for(int t=0;t<3;++t){ if(t<nt){
      if(t+1<nt) qkt_sw(pn0,pn1,kb0+(t+1)*SLOTB,qr,negm,negm,r32,hi);
      f32x16&p0=pc0; f32x16&p1=pc1;
      wmask(p0,p1,kbr0+t*64,qrel,hi);
      float a=__builtin_fmaxf(__builtin_fmaxf(p0[0],p0[1]),p1[0]),b=__builtin_fmaxf(__builtin_fmaxf(p0[2],p0[3]),p1[1]); a=__builtin_fmaxf(__builtin_fmaxf(a,p1[2]),p1[3]);
      #pragma unroll
      for(int r=4;r<16;r+=4){a=__builtin_fmaxf(__builtin_fmaxf(a,p0[r]),p0[r+1]);b=__builtin_fmaxf(__builtin_fmaxf(b,p0[r+2]),p0[r+3]);a=__builtin_fmaxf(__builtin_fmaxf(a,p1[r]),p1[r+1]);b=__builtin_fmaxf(__builtin_fmaxf(b,p1[r+2]),p1[r+3]);}
      float rm=__builtin_fmaxf(a,b); { auto rr=__builtin_amdgcn_permlane32_swap(__float_as_uint(rm),__float_as_uint(rm),false,false); rm=__builtin_fmaxf(__uint_as_float(rr[0]),__uint_as_float(rr[1])); }
      if(t==0){ const float dl=rm; mhat=dl;
        #pragma unroll
        for(int r=0;r<16;++r){p0[r]-=dl;p1[r]-=dl;pn0[r]-=dl;pn1[r]-=dl;}
        #pragma unroll
        for(int r=0;r<16;++r)negm[r]=-mhat; }
      else if(__builtin_expect(__any(rm>(float)THRL),0)){ const float dl=__builtin_fmaxf(rm,0.f); mhat+=dl;
        #pragma unroll
        for(int r=0;r<16;++r){p0[r]-=dl;p1[r]-=dl;}
        if(t+1<nt){
          #pragma unroll
          for(int r=0;r<16;++r){pn0[r]-=dl;pn1[r]-=dl;} }
        #pragma unroll
        for(int r=0;r<16;++r)negm[r]=-mhat;
        const float f=__builtin_amdgcn_exp2f(-dl); l_reg*=f; if(hi==0)wsf[r32]=f;
        #pragma unroll
        for(int d_=0;d_<2;++d_)
          #pragma unroll
          for(int r=0;r<16;++r)o[d_][r]*=wsf[crow(r,hi)]; }
      s16x4 vlo[8],vhi[8]; { const lds_cptr vp_=vp0s+t*SLOTB;
        #pragma unroll
        for(int i=0;i<8;++i){ vlo[i]=vtr(vp_+((i>>2)*4096+(i&3)*1024)); vhi[i]=vtr(vp_+((i>>2)*4096+(i&3)*1024+512)); } }
      #pragma unroll
      for(int r=0;r<16;++r){p0[r]=__builtin_amdgcn_exp2f(p0[r]);p1[r]=__builtin_amdgcn_exp2f(p1[r]);}
      float sacc=0.f;
      #pragma unroll
      for(int r=0;r<16;++r)sacc+=p0[r]+p1[r];
      l_reg+=sacc;
      u32x4 pw0=(u32x4){cvtpk_s(p0[0],p0[1]),cvtpk_s(p0[2],p0[3]),cvtpk_s(p0[4],p0[5]),cvtpk_s(p0[6],p0[7])},pw1=(u32x4){cvtpk_s(p0[8],p0[9]),cvtpk_s(p0[10],p0[11]),cvtpk_s(p0[12],p0[13]),cvtpk_s(p0[14],p0[15])},
            pw2=(u32x4){cvtpk_s(p1[0],p1[1]),cvtpk_s(p1[2],p1[3]),cvtpk_s(p1[4],p1[5]),cvtpk_s(p1[6],p1[7])},pw3=(u32x4){cvtpk_s(p1[8],p1[9]),cvtpk_s(p1[10],p1[11]),cvtpk_s(p1[12],p1[13]),cvtpk_s(p1[14],p1[15])};
      #define VFRS(i) (bf16x8){vlo[i][0],vlo[i][1],vlo[i][2],vlo[i][3],vhi[i][0],vhi[i][1],vhi[i][2],vhi[i][3]}
      o[0]=__builtin_amdgcn_mfma_f32_32x32x16_bf16(__builtin_bit_cast(bf16x8,pw0),VFRS(0),o[0],0,0,0); o[1]=__builtin_amdgcn_mfma_f32_32x32x16_bf16(__builtin_bit_cast(bf16x8,pw0),VFRS(4),o[1],0,0,0);
      o[0]=__builtin_amdgcn_mfma_f32_32x32x16_bf16(__builtin_bit_cast(bf16x8,pw1),VFRS(1),o[0],0,0,0); o[1]=__builtin_amdgcn_mfma_f32_32x32x16_bf16(__builtin_bit_cast(bf16x8,pw1),VFRS(5),o[1],0,0,0);
      o[0]=__builtin_amdgcn_mfma_f32_32x32x16_bf16(__builtin_bit_cast(bf16x8,pw2),VFRS(2),o[0],0,0,0); o[1]=__builtin_amdgcn_mfma_f32_32x32x16_bf16(__builtin_bit_cast(bf16x8,pw2),VFRS(6),o[1],0,0,0);
      o[0]=__builtin_amdgcn_mfma_f32_32x32x16_bf16(__builtin_bit_cast(bf16x8,pw3),VFRS(3),o[0],0,0,0); o[1]=__builtin_amdgcn_mfma_f32_32x32x16_bf16(__builtin_bit_cast(bf16x8,pw3),VFRS(7),o[1],0,0,0);
      #undef VFRS
      if(t+1<nt){ pc0=pn0; pc1=pn1; }
  } }
  {auto rr=__builtin_amdgcn_permlane32_swap(__float_as_uint(l_reg),__float_as_uint(l_reg),false,false);l_reg=__uint_as_float(rr[0])+__uint_as_float(rr[1]);}
  if(hi==0){ wsf[32+r32]=l_reg; *(__attribute__((address_space(1))) float*)(lse+(long)(i0+r32)*rs*lsep)=mhat+__builtin_amdgcn_logf(l_reg); }
  float rli[16];
  #pragma unroll
  for(int r=0;r<16;++r)rli[r]=__builtin_amdgcn_rcpf(wsf[32+crow(r,hi)]);
  { bf16*stg=(bf16*)(shm+DS_OST)+wid*2048; bf16*Ow=Oh+(long)i0*rs*opitch;
    #pragma unroll
    for(int r=0;r<16;++r){const int orow=crow(r,hi);
      #pragma unroll
      for(int d0=0;d0<2;++d0)stg[orow*64+d0*32+r32]=(bf16)(cvtpk_s(o[d0][r]*rli[r],0.f)&0xffffu);}
    #pragma unroll
    for(int i=0;i<4;++i){const int row=i*8+(lane>>3),ch=lane&7; const u32x4 v=*(const u32x4*)(stg+row*64+ch*8);
      *(__attribute__((address_space(1))) u32x4*)(Ow+(long)row*rs*opitch+ch*8)=v;} }
  asm volatile("s_waitcnt lgkmcnt(0)\n\ts_barrier":::"memory");
}
#undef SBAR
#undef WAIT_BAR
}

__device__ __forceinline__ void ld_row64(const bf16* p, float (&x)[64]) {
#pragma unroll
    for (int i = 0; i < 8; ++i) { const v4u w = *((const GAS v4u*)p + i);
        x[8 * i + 0] = bflo(w.x); x[8 * i + 1] = bfhi(w.x); x[8 * i + 2] = bflo(w.y); x[8 * i + 3] = bfhi(w.y);
        x[8 * i + 4] = bflo(w.z); x[8 * i + 5] = bfhi(w.z); x[8 * i + 6] = bflo(w.w); x[8 * i + 7] = bfhi(w.w); }
}
__device__ __forceinline__ float dot_row64(const bf16* kp, const float (&q)[64]) {
    float s0 = 0.f, s1 = 0.f;
#pragma unroll
    for (int i = 0; i < 8; ++i) { const v4u w = *((const GAS v4u*)kp + i);
        s0 += q[8 * i + 0] * bflo(w.x); s1 += q[8 * i + 1] * bfhi(w.x); s0 += q[8 * i + 2] * bflo(w.y); s1 += q[8 * i + 3] * bfhi(w.y);
        s0 += q[8 * i + 4] * bflo(w.z); s1 += q[8 * i + 5] * bfhi(w.z); s0 += q[8 * i + 6] * bflo(w.w); s1 += q[8 * i + 7] * bfhi(w.w); }
    return s0 + s1;
}
__device__ __forceinline__ void sm_update(float s, const bf16* vp, float& mx, float& l, float (&o)[64]) {
    const float mn = fmaxf(mx, s); const float a = __builtin_amdgcn_exp2f(mx - mn), p = __builtin_amdgcn_exp2f(s - mn);
    mx = mn; l = l * a + p;
#pragma unroll
    for (int i = 0; i < 8; ++i) { const v4u w = *((const GAS v4u*)vp + i);
        o[8 * i + 0] = o[8 * i + 0] * a + p * bflo(w.x); o[8 * i + 1] = o[8 * i + 1] * a + p * bfhi(w.x); o[8 * i + 2] = o[8 * i + 2] * a + p * bflo(w.y); o[8 * i + 3] = o[8 * i + 3] * a + p * bfhi(w.y);
        o[8 * i + 4] = o[8 * i + 4] * a + p * bflo(w.z); o[8 * i + 5] = o[8 * i + 5] * a + p * bfhi(w.z); o[8 * i + 6] = o[8 * i + 6] * a + p * bflo(w.w); o[8 * i + 7] = o[8 * i + 7] * a + p * bfhi(w.w); }
}
__device__ __forceinline__ void st_row64(bf16* p, const float (&o)[64], float inv) {
#pragma unroll
    for (int i = 0; i < 8; ++i) { v4u w; w.x = pk2(o[8 * i] * inv, o[8 * i + 1] * inv); w.y = pk2(o[8 * i + 2] * inv, o[8 * i + 3] * inv); w.z = pk2(o[8 * i + 4] * inv, o[8 * i + 5] * inv); w.w = pk2(o[8 * i + 6] * inv, o[8 * i + 7] * inv);
        *((GAS v4u*)p + i) = w; }
}
__device__ __forceinline__ void fox_simple(Frame& F, const bf16* Q, const bf16* K, const bf16* V, const float* BIASC, bf16* Y) {
    for (int task = F.bid * NWAVES + F.wave; task < 16 * 128; task += F.G * NWAVES) {
        const int bh = task >> 7, r = task & 127, j = r >> 3, w = r & 7; const int base = 32 * (w >> 1); const int tblk = (w & 1) ? base + 31 - j : base + j;
        const int b = bh >> 2, h = bh & 3; const int t = tblk * 64 + F.lane; const int tmax = tblk * 64 + 63;
        const size_t rb = (size_t)b * SEQ;
        float q[64], o[64]; ld_row64(Q + (rb + t) * DM + h * 64, q);
#pragma unroll
        for (int d = 0; d < 64; ++d) o[d] = 0.f;
        float mx = -INFINITY, l = 0.f;
        const float* bc = BIASC + ((size_t)b * 4 + h) * SEQ;
        for (int kk = 0; kk <= tmax; ++kk) {
            const bf16* kp = K + (rb + kk) * DM + h * 64; const bf16* vp = V + (rb + kk) * DM + h * 64;
            const float s = dot_row64(kp, q) + bc[kk];
            if (kk <= t) sm_update(s, vp, mx, l, o);
        }
        st_row64(Y + (rb + t) * YP + h * 64, o, 1.f / l);
    }
}
__device__ __forceinline__ void moba_simple(Frame& F, const bf16* Q, const bf16* K, const bf16* V, const float* KMP, bf16* Y) {
    const int gtid = F.bid * (NWAVES * 64) + F.tid, NT = F.G * NWAVES * 64;
    for (int g = gtid; g < BATCH * 6 * SEQ; g += NT) {
        const int bhm = g / SEQ, t = g % SEQ, b = bhm / 6, hm = bhm % 6, head = 10 + hm; const size_t rb = (size_t)b * SEQ;
        float q[64], o[64]; ld_row64(Q + (rb + t) * DM + head * 64, q);
#pragma unroll
        for (int d = 0; d < 64; ++d) o[d] = 0.f;
        const int own = t >> 8;
        float g0 = -INFINITY, g1 = -INFINITY, g2 = -INFINITY; int i0 = -1, i1 = -1, i2 = -1;
        for (int n = 0; n < own; ++n) {
            const float* k0 = KMP + ((size_t)(b * 32 + n) * 2) * DM + head * 64; const float* k1 = k0 + DM;
            float s = 0.f;
#pragma unroll
            for (int d = 0; d < 64; ++d) s += q[d] * (k0[d] + k1[d]);
            if (s > g0) { g2 = g1; i2 = i1; g1 = g0; i1 = i0; g0 = s; i0 = n; }
            else if (s > g1) { g2 = g1; i2 = i1; g1 = s; i1 = n; }
            else if (s > g2) { g2 = s; i2 = n; }
        }
        float mx = -INFINITY, l = 0.f;
        for (int c = 0; c < 4; ++c) {
            const int blk = c == 0 ? own : (c == 1 ? i0 : (c == 2 ? i1 : i2));
            if (blk < 0) continue;
            const int kend = (c == 0) ? (t & 255) : 255;
            for (int kk = 0; kk <= kend; ++kk) {
                const size_t row = rb + blk * 256 + kk;
                const float s = dot_row64(K + row * DM + head * 64, q);
                sm_update(s, V + row * DM + head * 64, mx, l, o);
            }
        }
        st_row64(Y + (rb + t) * YP + 384 + hm * 64, o, 1.f / l);
    }
}
__device__ __forceinline__ void dil_simple(Frame& F, const bf16* Q, const bf16* K, const bf16* V, bf16* Y) {
    const int gtid = F.bid * (NWAVES * 64) + F.tid, NT = F.G * NWAVES * 64;
    for (int g = gtid; g < BATCH * 2 * SEQ; g += NT) {
        const int b = g / (2 * SEQ), hg = (g / SEQ) & 1, t = g % SEQ; const size_t rb = (size_t)b * SEQ;
        float q[64], o[64];
#pragma unroll
        for (int d = 0; d < 64; ++d) o[d] = 0.f;
        float mx = -INFINITY, l = 0.f;
        for (int grp = 0; grp < 3; ++grp) {
            const int head = 4 + 2 * grp + hg, dil = grp == 0 ? 1 : (grp == 1 ? 4 : 16);
            ld_row64(Q + (rb + t) * DM + head * 64, q);
            for (int n = 0; n <= 128; ++n) {
                const int kp = t - n * dil; if (kp < 0) break;
                const size_t row = rb + kp;
                const float s = dot_row64(K + row * DM + head * 64, q);
                sm_update(s, V + row * DM + head * 64, mx, l, o);
            }
        }
        st_row64(Y + (rb + t) * YP + 256 + hg * 64, o, 1.f / l);
    }
}

#ifndef FP8_UP_FROM_LAYER
#define FP8_UP_FROM_LAYER 1
#endif
#ifndef FP8_DOWN_FROM_LAYER
#define FP8_DOWN_FROM_LAYER 1
#endif
#ifndef ROUTED_MOBA
#define ROUTED_MOBA 1
#endif
#ifndef FAST_MOBA
#define FAST_MOBA 1
#endif
#ifndef FAST_FOX
#define FAST_FOX 1
#endif
#ifndef FAST_DIL
#define FAST_DIL 1
#endif
constexpr size_t WS_OD = 400 * MiB;
constexpr size_t WS_LSE = 5 * MiB;
constexpr int CW_LCNT = 16384;
constexpr int CW_RQ = 20480;
constexpr size_t WS_PO = 424 * MiB;
constexpr size_t OUT_PL = 64 * MiB;
constexpr size_t OUT_XN8 = 80 * MiB;
constexpr size_t OUT_LIST = 68 * MiB;
constexpr int PRE_OFF = 102400;
constexpr int CW_STAT = 14336;
constexpr int CW_Q = 8192;
__device__ __forceinline__ void q_prefetch(Frame& F, unsigned* ctr, int& pre) {
    if (F.tid == 0) pre = (int)__hip_atomic_fetch_add(ctr + 64 * (int)(xb_xcc_id() & 7u), 1u, __ATOMIC_RELAXED, __HIP_MEMORY_SCOPE_AGENT);
}
__device__ __forceinline__ int q_take(Frame& F, unsigned* ctr, int nper, int pre) {
    LAS int* qw = (LAS int*)(F.lds + RING_OFF + attn_body::LDS_TAB + 384);
    if (F.tid == 0) {
        const int x = (int)(xb_xcc_id() & 7u); int res = -1;
        if (pre < nper) res = x * nper + pre;
        else for (int k = 1; k < 8; ++k) { const int xx = (x + k) & 7; const int id = (int)__hip_atomic_fetch_add(ctr + 64 * xx, 1u, __ATOMIC_RELAXED, __HIP_MEMORY_SCOPE_AGENT); if (id < nper) { res = xx * nper + id; break; } }
        *qw = res;
    }
    asm volatile("s_waitcnt lgkmcnt(0)\n\ts_barrier" ::: "memory");
    const int id = *qw;
    asm volatile("s_waitcnt lgkmcnt(0)\n\ts_barrier" ::: "memory");
    return __builtin_amdgcn_readfirstlane(id);
}
__device__ __forceinline__ void moba_fast(Frame& F, char* shm, unsigned* ctr, const bf16* Q, const bf16* K, const bf16* V, const float* KMP, bf16* Y) {
    int pre = 0; q_prefetch(F, ctr, pre);
    for (;;) { const int i = q_take(F, ctr, 96, pre); if (i < 0) break; q_prefetch(F, ctr, pre);
        const int xx = i / 96, id = i % 96, sidx = xx * 3 + (id % 3), qb = 31 - (id / 3), b = sidx / 6, hm = sidx % 6, head = 10 + hm;       const size_t rb = (size_t)b * SEQ;
        attn_body::UnitP U; U.Qh = Q + rb * DM + head * 64; U.Kh = K + rb * DM + head * 64; U.Vh = V + rb * DM + head * 64; U.Oh = Y + rb * YP + 384 + hm * 64; U.opitch = YP; U.rs = 1; U.q0 = qb * 256;
        U.t0 = 0; U.NT = 4; U.bias = nullptr; U.kmp = KMP + (size_t)(b * 32) * 2048 + head * 64; U.own = qb; U.lse = nullptr;
        attn_body::attn_unit<1, 8>(U, shm); }
}
__device__ __forceinline__ void fox_fast(Frame& F, char* shm, unsigned* ctr, const bf16* Q, const bf16* K, const bf16* V, const bf16* BIASK, const float* BIASC, const unsigned* stat, bf16* Y) {
    int pre = 0; q_prefetch(F, ctr, pre);
    for (;;) { const int i = q_take(F, ctr, 64, pre); if (i < 0) break; q_prefetch(F, ctr, pre);
        const int xx = i / 64, id = i % 64, sidx = xx * 2 + (id >> 5), qb = 31 - (id & 31), b = sidx >> 2, h = sidx & 3; const size_t rb = (size_t)b * SEQ;
        const float* bc = BIASC + ((size_t)b * 4 + h) * SEQ; const int q0 = qb * 256;
        const unsigned* sq = stat + ((b * 2 + 0) * 4 + h) * 2; const unsigned* sk = stat + ((b * 2 + 1) * 4 + h) * 2;
        const float q2 = __uint_as_float(sq[0]) + __uint_as_float(sq[1]), k2 = __uint_as_float(sk[0]) + __uint_as_float(sk[1]);
        const float lim = bc[q0] - (2.f * sqrtf(q2 * k2) + 42.f);
        const int pos = 64 * (2 * F.lane + 2) - 1; const bool ok = (pos < q0) && (bc[pos < q0 ? pos : 0] <= lim);
        const int tmin = 2 * __builtin_popcountll(__ballot(ok));
        attn_body::UnitP U; U.Qh = Q + rb * DM + h * 64; U.Kh = K + rb * DM + h * 64; U.Vh = V + rb * DM + h * 64; U.Oh = Y + rb * YP + h * 64; U.opitch = YP; U.rs = 1; U.q0 = q0;
        U.t0 = __builtin_amdgcn_readfirstlane(tmin); U.NT = 4 * qb + 4 - U.t0; U.bias = BIASK + ((size_t)b * 4 + h) * SEQ * 8; U.kmp = nullptr; U.own = 0; U.lse = nullptr;
        attn_body::attn_unit<0, 8>(U, shm); }
}
__device__ __forceinline__ void dil_fast(Frame& F, char* shm, unsigned* ctr, const bf16* Q, const bf16* K, const bf16* V, bf16* OD, float* LSE) {
    int pre = 0; q_prefetch(F, ctr, pre);
    for (;;) { const int i = q_take(F, ctr, 96, pre); if (i < 0) break; q_prefetch(F, ctr, pre);
        const int b = i / 192, rem = i % 192, hd = rem >> 5, ur = rem & 31, g2 = 2 * (hd >> 1), dil = 1 << g2, r = ur & (dil - 1), sb = ur >> g2, head = 4 + hd; const size_t rb = (size_t)b * SEQ + r;
        attn_body::UnitP U; U.Qh = Q + rb * DM + head * 64; U.Kh = K + rb * DM + head * 64; U.Vh = V + rb * DM + head * 64; U.Oh = OD + rb * 384 + hd * 64; U.opitch = 384; U.rs = dil; U.q0 = sb * 256;
        attn_body::dil_stat_unit<8>(U.Qh, U.Kh, U.Vh, dil, sb, U.Oh, 384, LSE + rb * 6 + hd, 6, shm); }
}
__device__ __forceinline__ void moba_gate_pass(Frame& F, char* shm, unsigned* ctr, const bf16* Q, const bf16* K, const bf16* V, const float* KMP, unsigned* lcnt_g, unsigned short* LISTS, float* PL, bf16* Y) {
    int pre = 0; q_prefetch(F, ctr, pre);
    for (;;) { const int i = q_take(F, ctr, 96, pre); if (i < 0) break; q_prefetch(F, ctr, pre);
        const int xx = i / 96, id = i % 96, sidx = xx * 3 + (id % 3), qb = 31 - (id / 3), b = sidx / 6, hm = sidx % 6, head = 10 + hm; const size_t rb = (size_t)b * SEQ;
        attn_body::UnitP U; U.Qh = Q + rb * DM + head * 64; U.Kh = K + rb * DM + head * 64; U.Vh = V + rb * DM + head * 64; U.Oh = Y + rb * YP + 384 + hm * 64; U.opitch = YP; U.rs = 1; U.q0 = qb * 256;
        U.t0 = 4 * qb; U.NT = 4; U.bias = nullptr; U.kmp = KMP + (size_t)(b * 32) * 2048 + head * 64; U.own = qb; U.lse = PL + (rb * 6 + hm) * 4 + 3; U.lsep = 24;
        U.list = nullptr; U.cnt = 0; U.e0 = 0; U.PO = nullptr; U.PL = nullptr; U.rowbase6 = 0; U.glcnt = lcnt_g + (b * 6 + hm) * 32; U.glist = LISTS + (size_t)((b * 6 + hm) * 32) * 8192;
        attn_body::attn_unit<6, 8>(U, shm); }
}
__device__ __forceinline__ void attn_l2a(Frame& F, char* shm, unsigned* ctr, const bf16* Q, const bf16* K, const bf16* V, const bf16* BIASK, const float* BIASC, const unsigned* stat, const float* KMP,
                                         unsigned* lcnt_g, unsigned short* LISTS, float* PL, bf16* Y, bf16* OD, float* LSE) {
    int pre = 0; q_prefetch(F, ctr, pre);
    for (;;) { const int i = q_take(F, ctr, 256, pre); if (i < 0) break; q_prefetch(F, ctr, pre);
        const int xx = i >> 8, idc = i & 255;
        if (idc < 64) { const int id = idc;
            const int sidx = xx * 2 + (id >> 5), qb = 31 - (id & 31), b = sidx >> 2, h = sidx & 3; const size_t rb = (size_t)b * SEQ;
            const float* bc = BIASC + ((size_t)b * 4 + h) * SEQ; const int q0 = qb * 256;
            const unsigned* sq = stat + ((b * 2 + 0) * 4 + h) * 2; const unsigned* sk = stat + ((b * 2 + 1) * 4 + h) * 2;
            const float q2 = __uint_as_float(sq[0]) + __uint_as_float(sq[1]), k2 = __uint_as_float(sk[0]) + __uint_as_float(sk[1]);
            const float lim = bc[q0] - (2.f * sqrtf(q2 * k2) + 42.f);
            const int pos = 64 * (2 * F.lane + 2) - 1; const bool ok = (pos < q0) && (bc[pos < q0 ? pos : 0] <= lim);
            const int tmin = 2 * __builtin_popcountll(__ballot(ok));
            attn_body::UnitP U; U.Qh = Q + rb * DM + h * 64; U.Kh = K + rb * DM + h * 64; U.Vh = V + rb * DM + h * 64; U.Oh = Y + rb * YP + h * 64; U.opitch = YP; U.rs = 1; U.q0 = q0;
            U.t0 = __builtin_amdgcn_readfirstlane(tmin); U.NT = 4 * qb + 4 - U.t0; U.bias = BIASK + ((size_t)b * 4 + h) * SEQ * 8; U.kmp = nullptr; U.own = 0; U.lse = nullptr;
            attn_body::attn_unit<0, 8>(U, shm);
        } else if (idc < 160) { const int id = idc - 64;
            const int sidx = xx * 3 + (id % 3), qb = 31 - (id / 3), b = sidx / 6, hm = sidx % 6, head = 10 + hm; const size_t rb = (size_t)b * SEQ;
            attn_body::UnitP U; U.Qh = Q + rb * DM + head * 64; U.Kh = K + rb * DM + head * 64; U.Vh = V + rb * DM + head * 64; U.Oh = Y + rb * YP + 384 + hm * 64; U.opitch = YP; U.rs = 1; U.q0 = qb * 256;
            U.t0 = 4 * qb; U.NT = 4; U.bias = nullptr; U.kmp = KMP + (size_t)(b * 32) * 2048 + head * 64; U.own = qb; U.lse = PL + (rb * 6 + hm) * 4 + 3; U.lsep = 24;
            U.list = nullptr; U.cnt = 0; U.e0 = 0; U.PO = nullptr; U.PL = nullptr; U.rowbase6 = 0; U.glcnt = lcnt_g + (b * 6 + hm) * 32; U.glist = LISTS + (size_t)((b * 6 + hm) * 32) * 8192;
            attn_body::attn_unit<6, 8>(U, shm);
        } else { const int j = xx * 96 + (idc - 160);
            const int b = j / 192, rem = j % 192, hd = rem >> 5, ur = rem & 31, g2 = 2 * (hd >> 1), dil = 1 << g2, r = ur & (dil - 1), sb = ur >> g2, head = 4 + hd; const size_t rb = (size_t)b * SEQ + r;
            attn_body::dil_stat_unit<8>(Q + rb * DM + head * 64, K + rb * DM + head * 64, V + rb * DM + head * 64, dil, sb, OD + rb * 384 + hd * 64, 384, LSE + rb * 6 + hd, 6, shm);
        }
    }
}
constexpr int RPART = 1024;
__device__ __forceinline__ void moba_routed_pass(Frame& F, char* shm, unsigned* rq, const unsigned* lcnt_g, const unsigned short* LISTS, const bf16* Q, const bf16* K, const bf16* V, bf16* PO, float* PL) {
    LAS int* pre = (LAS int*)(F.lds + RING_OFF + PRE_OFF);
    { const int i0 = F.tid, i1 = F.tid + 512;
      const int n0_ = (int)lcnt_g[(i0 % 24) * 32 + i0 / 24]; int n1_ = 0; if (i1 < 768) n1_ = (int)lcnt_g[(i1 % 24) * 32 + i1 / 24];
      pre[i0] = (n0_ + RPART - 1) / RPART; pre[896 + i0] = n0_; if (i1 < 768) { pre[i1] = (n1_ + RPART - 1) / RPART; pre[896 + i1] = n1_; }
      __syncthreads();
      if (F.tid < 64) { int run = 0;
#pragma unroll 1
          for (int j = 0; j < 12; ++j) { const int idx = F.tid * 12 + j; run += pre[idx]; pre[idx] = run; } }
      __syncthreads();
      if (F.tid == 0) { int run = 0;
#pragma unroll 1
          for (int s = 0; s < 64; ++s) { const int e = pre[s * 12 + 11]; pre[768 + s] = run; run += e; } }
      __syncthreads();
      { const int a0 = pre[768 + i0 / 12]; int a1 = 0; if (i1 < 768) a1 = pre[768 + i1 / 12]; __syncthreads(); pre[i0] += a0; if (i1 < 768) pre[i1] += a1; }
      __syncthreads(); }
    const int NU = pre[767];
    LAS int* qw = pre + 2048;
    int nxt = 0;
    if (F.tid == 0) nxt = (int)__hip_atomic_fetch_add(rq, 1u, __ATOMIC_RELAXED, __HIP_MEMORY_SCOPE_AGENT);
    for (;;) {
        if (F.tid == 0) *qw = nxt;
        asm volatile("s_waitcnt lgkmcnt(0)\n\ts_barrier" ::: "memory");
        const int i = __builtin_amdgcn_readfirstlane(*qw);
        asm volatile("s_waitcnt lgkmcnt(0)\n\ts_barrier" ::: "memory");
        if (i >= NU) break;
        if (F.tid == 0) nxt = (int)__hip_atomic_fetch_add(rq, 1u, __ATOMIC_RELAXED, __HIP_MEMORY_SCOPE_AGENT);
        int lo = 0, hi_ = 767;
        while (lo < hi_) { const int mid = (lo + hi_) >> 1; if (pre[mid] > i) hi_ = mid; else lo = mid + 1; }
        const int j = lo, part = i - (j > 0 ? pre[j - 1] : 0), n = j / 24, bh = j % 24, L = bh * 32 + n, b = bh / 6, hm = bh % 6, head = 10 + hm; const size_t rb = (size_t)b * SEQ;
        const int len = __builtin_amdgcn_readfirstlane(pre[896 + j]); const int e0 = part * RPART, e1 = min(len, e0 + RPART);
        attn_body::routed_stat_unit<8>(Q + rb * DM + head * 64, K + rb * DM + head * 64, V + rb * DM + head * 64, LISTS + (size_t)L * 8192, e0, e1, n, PO, PL, (int)(rb * 6) + hm, shm);
    }
}
__device__ __forceinline__ void moba_combine(Frame& F, const bf16* PO, const float* PL, bf16* Y) {
    const int gtid = F.bid * (NWAVES * 64) + F.tid, NT = F.G * NWAVES * 64;
    struct It { f32x4 l4; v4u o, a, b, c; int ns; GAS v4u* yp; };
    auto ld = [&](It& I, int it) {
        const int m = it / 48, rem = it % 48, hm = rem >> 3, d0 = (rem & 7) * 8; I.ns = min(3, (m & (SEQ - 1)) >> 8);
        const size_t qi = (size_t)m * 6 + hm; I.l4 = __builtin_nontemporal_load((const GAS f32x4*)(PL + qi * 4));
        I.yp = (GAS v4u*)(Y + (size_t)m * YP + 384 + hm * 64 + d0); I.o = *I.yp; const v4u z = (v4u){0u, 0u, 0u, 0u};
        I.a = I.ns > 0 ? __builtin_nontemporal_load((const GAS v4u*)(PO + (qi * 3 + 0) * 64 + d0)) : z; I.b = I.ns > 1 ? __builtin_nontemporal_load((const GAS v4u*)(PO + (qi * 3 + 1) * 64 + d0)) : z; I.c = I.ns > 2 ? __builtin_nontemporal_load((const GAS v4u*)(PO + (qi * 3 + 2) * 64 + d0)) : z; };
    auto fin = [&](const It& I) {
        const float l0 = I.ns > 0 ? I.l4.x : -INFINITY, l1 = I.ns > 1 ? I.l4.y : -INFINITY, l2 = I.ns > 2 ? I.l4.z : -INFINITY, lo = I.l4.w;
        const float mx = fmaxf(fmaxf(l0, l1), fmaxf(l2, lo));
        float w0 = __builtin_amdgcn_exp2f(l0 - mx), w1 = __builtin_amdgcn_exp2f(l1 - mx), w2 = __builtin_amdgcn_exp2f(l2 - mx), wo = __builtin_amdgcn_exp2f(lo - mx);
        const float inv = 1.f / ((w0 + w1) + (w2 + wo)); w0 *= inv; w1 *= inv; w2 *= inv; wo *= inv;
        const v4u o = I.o, a = I.a, b = I.b, c = I.c; v4u r;
        r.x = pk2(wo * bflo(o.x) + w0 * bflo(a.x) + w1 * bflo(b.x) + w2 * bflo(c.x), wo * bfhi(o.x) + w0 * bfhi(a.x) + w1 * bfhi(b.x) + w2 * bfhi(c.x));
        r.y = pk2(wo * bflo(o.y) + w0 * bflo(a.y) + w1 * bflo(b.y) + w2 * bflo(c.y), wo * bfhi(o.y) + w0 * bfhi(a.y) + w1 * bfhi(b.y) + w2 * bfhi(c.y));
        r.z = pk2(wo * bflo(o.z) + w0 * bflo(a.z) + w1 * bflo(b.z) + w2 * bflo(c.z), wo * bfhi(o.z) + w0 * bfhi(a.z) + w1 * bfhi(b.z) + w2 * bfhi(c.z));
        r.w = pk2(wo * bflo(o.w) + w0 * bflo(a.w) + w1 * bflo(b.w) + w2 * bflo(c.w), wo * bfhi(o.w) + w0 * bfhi(a.w) + w1 * bfhi(b.w) + w2 * bfhi(c.w));
        *I.yp = r; };
    for (int it = gtid; it < M * 48; it += 3 * NT) {
        It A, B, C; ld(A, it); const bool hb = it + NT < M * 48, hc = it + 2 * NT < M * 48; if (hb) ld(B, it + NT); if (hc) ld(C, it + 2 * NT);
        fin(A); if (hb) fin(B); if (hc) fin(C);
    }
}
__device__ __forceinline__ void dil_merge(Frame& F, const bf16* OD, const float* LSE, bf16* Y) {
    const int gtid = F.bid * (NWAVES * 64) + F.tid, NT = F.G * NWAVES * 64;
    struct It { float l0, l1, l2; v4u a, b, c; GAS v4u* yp; };
    auto ld = [&](It& I, int it) {
        const int m = it >> 4, c8 = it & 15, hg = c8 >> 3, d0 = (c8 & 7) * 8;
        I.l0 = LSE[(size_t)m * 6 + hg]; I.l1 = LSE[(size_t)m * 6 + 2 + hg]; I.l2 = LSE[(size_t)m * 6 + 4 + hg];
        I.a = __builtin_nontemporal_load((const GAS v4u*)(OD + (size_t)m * 384 + hg * 64 + d0)); I.b = __builtin_nontemporal_load((const GAS v4u*)(OD + (size_t)m * 384 + (2 + hg) * 64 + d0)); I.c = __builtin_nontemporal_load((const GAS v4u*)(OD + (size_t)m * 384 + (4 + hg) * 64 + d0));
        I.yp = (GAS v4u*)(Y + (size_t)m * YP + 256 + hg * 64 + d0); };
    auto fin = [&](const It& I) {
        const float mx = fmaxf(I.l0, fmaxf(I.l1, I.l2));
        float w0 = __builtin_amdgcn_exp2f(I.l0 - mx), w1 = __builtin_amdgcn_exp2f(I.l1 - mx), w2 = __builtin_amdgcn_exp2f(I.l2 - mx);
        const float inv = 1.f / (w0 + w1 + w2); w0 *= inv; w1 *= inv; w2 *= inv;
        const v4u a = I.a, b = I.b, c = I.c; v4u o;
        o.x = pk2(w0 * bflo(a.x) + w1 * bflo(b.x) + w2 * bflo(c.x), w0 * bfhi(a.x) + w1 * bfhi(b.x) + w2 * bfhi(c.x));
        o.y = pk2(w0 * bflo(a.y) + w1 * bflo(b.y) + w2 * bflo(c.y), w0 * bfhi(a.y) + w1 * bfhi(b.y) + w2 * bfhi(c.y));
        o.z = pk2(w0 * bflo(a.z) + w1 * bflo(b.z) + w2 * bflo(c.z), w0 * bfhi(a.z) + w1 * bfhi(b.z) + w2 * bfhi(c.z));
        o.w = pk2(w0 * bflo(a.w) + w1 * bflo(b.w) + w2 * bflo(c.w), w0 * bfhi(a.w) + w1 * bfhi(b.w) + w2 * bfhi(c.w));
        *I.yp = o; };
    for (int it = gtid; it < M * 16; it += 4 * NT) {
        It A, B, C, D; const bool hb = it + NT < M * 16, hc = it + 2 * NT < M * 16, hd = it + 3 * NT < M * 16;
        ld(A, it); if (hb) ld(B, it + NT); if (hc) ld(C, it + 2 * NT); if (hd) ld(D, it + 3 * NT);
        fin(A); if (hb) fin(B); if (hc) fin(C); if (hd) fin(D);
    }
}

template <int OFF> __device__ __forceinline__ unsigned long long karg64() {
    unsigned long long v; auto kp = __builtin_amdgcn_kernarg_segment_ptr();
    asm volatile("s_load_dwordx2 %0, %1, %2\n\ts_waitcnt lgkmcnt(0)" : "=s"(v) : "s"(kp), "n"(OFF) : "memory");
    return v;
}
template <int OFF> __device__ __forceinline__ int karg32() {
    int v; auto kp = __builtin_amdgcn_kernarg_segment_ptr();
    asm volatile("s_load_dword %0, %1, %2\n\ts_waitcnt lgkmcnt(0)" : "=s"(v) : "s"(kp), "n"(OFF) : "memory");
    return v;
}
#define INP(i) ((const float*)(const GAS float*)karg64<8 * (i)>())
#define OUTP() ((float*)(GAS float*)karg64<144>())
#define WSP() ((unsigned char*)(GAS unsigned char*)karg64<152>())
#define WSB(off) ((bf16*)(WSP() + (off)))
#define WSF(off) ((float*)(WSP() + (off)))
#define WLAYER(l) ((const bf16*)(WSP() + WS_W + (size_t)(l) * W_LAYER_BYTES))

__global__ void __launch_bounds__(NWAVES * 64, 2) fwd_kernel(Args args_unused) {
    extern __shared__ __attribute__((aligned(16))) unsigned char lds[];
    Frame F;
    F.lds = (LAS unsigned char*)lds; F.tid = threadIdx.x; F.lane = F.tid & 63; F.wave = __builtin_amdgcn_readfirstlane(F.tid >> 6); F.G = gridDim.x; F.bid = blockIdx.x;
    for (int u = F.tid; u < (LDS_BYTES - LDSCTL_OFF) / 4; u += NWAVES * 64) ((LAS unsigned*)(F.lds + LDSCTL_OFF))[u] = 0u;
    __syncthreads();
    volatile LAS unsigned* MISC = (volatile LAS unsigned*)(F.lds + MISC_OFF);
    XcdBarrier bar = xcd_barrier_post((unsigned*)(WSP() + WS_CTL) + CW_BAR, MISC + 8);
    const int lo = karg32<160>(), hi = karg32<164>();
    int phase = 0;
#define PH_BEGIN if (phase >= lo && phase < hi) { { int t_ = threadIdx.x, b_ = blockIdx.x, g_ = gridDim.x; asm volatile("" : "+v"(t_), "+v"(b_), "+v"(g_)); \
        F.tid = t_; F.lane = t_ & 63; F.wave = __builtin_amdgcn_readfirstlane(t_ >> 6); F.bid = __builtin_amdgcn_readfirstlane(b_); F.G = __builtin_amdgcn_readfirstlane(g_); }
#define PH_END(dobar) if ((dobar) && phase + 1 < hi) xcd_barrier(bar); } ++phase;

    PH_BEGIN
    {
        const int gtid = F.bid * (NWAVES * 64) + F.tid, NT = F.G * NWAVES * 64;
        float* TAB = WSF(WS_TAB);
        for (int e = gtid; e < SEQ * 32; e += NT) {
            const int t = e >> 5, i = e & 31;
            const float inv = 1.0f / powf(10000.0f, (float)(2 * i) * (1.0f / 64.0f));
            const float ang = (float)t * inv;
            const double rev = (double)ang * 0.15915494309189535; const float fr = (float)(rev - __builtin_rint(rev));
            TAB[e] = __builtin_amdgcn_cosf(fr); TAB[SEQ * 32 + e] = __builtin_amdgcn_sinf(fr);
        }
        LAS float* scr = (LAS float*)(F.lds + RING_OFF + F.wave * 16384);
        const int gw = F.bid * NWAVES + F.wave, NGW = F.G * NWAVES;
        constexpr int I_QKV = 16 * 32, I_G = 16 * 96, I_BA = 4 * 32, I_BB = 2 * 32, I_BC = 6 * 32, I_O = 16 * 32, I_F = 16 * 88, I_D = 44 * 32, I_P = 4 * 32, I_PG = 16 * 32;
        constexpr int I_LAYER = 3 * I_QKV + I_G + I_BA + I_BB + I_BC + I_O + 2 * I_F + I_D + I_P + I_PG;
        for (int it = gw; it < DEPTH * I_LAYER; it += NGW) {
            const int l = it / I_LAYER; int r = it % I_LAYER;
            bf16* WL = (bf16*)(WSP() + WS_W + (size_t)l * W_LAYER_BYTES);
            if (r < 3 * I_QKV + I_G) {
                const float* w_in = INP(3) + (size_t)l * DM * WINC;
                if (r < I_QKV) { wconv_item(w_in, WINC, 0, 1024, WL + OW_IN, 1024, 0, MAP_ROPE, 0, scr, r, F.lane); continue; } r -= I_QKV;
                if (r < I_QKV) { wconv_item(w_in, WINC, 1024, 1024, WL + OW_IN, 1024, 0, MAP_ROPE, 1024, scr, r, F.lane); continue; } r -= I_QKV;
                if (r < I_QKV) { wconv_item(w_in, WINC, 2048, 1024, WL + OW_IN, 1024, 0, MAP_P8, 2048, scr, r, F.lane); continue; } r -= I_QKV;
                wconv8_item(w_in, WINC, 3076, 3072, (unsigned char*)(WL + OW_IN + (size_t)3072 * 1024), scr, r, F.lane); continue;
            }
            r -= 3 * I_QKV + I_G;
            if (r < I_BA) { wconv_item(INP(5) + (size_t)l * 256 * DM, DM, 0, 1024, WL + OW_BR, 1024, 0, MAP_P8, 0, scr, r, F.lane); continue; } r -= I_BA;
            if (r < I_BB) { wconv_item(INP(6) + (size_t)l * 128 * DM, DM, 0, 1024, WL + OW_BR, 1024, 256, MAP_P8, 0, scr, r, F.lane); continue; } r -= I_BB;
            if (r < I_BC) { wconv_item(INP(7) + (size_t)l * 384 * DM, DM, 0, 1024, WL + OW_BR, 1024, 384, MAP_P8, 0, scr, r, F.lane); continue; } r -= I_BC;
            if (r < I_O) { wconv_item(INP(8) + (size_t)l * DM * DM, DM, 0, 1024, WL + OW_OUT, 1024, 0, MAP_P8, 0, scr, r, F.lane); continue; } r -= I_O;
            if (r < I_F) { if (l >= FP8_UP_FROM_LAYER) wconv8_item(INP(11) + (size_t)l * DM * DFF, DFF, 0, DFF, (unsigned char*)(WL + OW_GU), scr, r, F.lane, 1024, 64.0f, MAP_GU0);
                           else wconv_item(INP(11) + (size_t)l * DM * DFF, DFF, 0, DFF, WL + OW_GU, 1024, 0, MAP_GU0, 0, scr, r, F.lane); continue; } r -= I_F;
            if (r < I_F) { if (l >= FP8_UP_FROM_LAYER) wconv8_item(INP(12) + (size_t)l * DM * DFF, DFF, 0, DFF, (unsigned char*)(WL + OW_GU), scr, r, F.lane, 1024, 64.0f, MAP_GU1);
                           else wconv_item(INP(12) + (size_t)l * DM * DFF, DFF, 0, DFF, WL + OW_GU, 1024, 0, MAP_GU1, 0, scr, r, F.lane); continue; } r -= I_F;
            if (r < I_D) { if (l >= FP8_DOWN_FROM_LAYER) wconv8_item(INP(13) + (size_t)l * DFF * DM, DM, 0, 1024, (unsigned char*)(WL + OW_DN), scr, r, F.lane, DFF, 64.0f);
                           else wconv_item(INP(13) + (size_t)l * DFF * DM, DM, 0, 1024, WL + OW_DN, DFF, 0, MAP_P8, 0, scr, r, F.lane); continue; } r -= I_D;
            if (r < I_P) { wconv_item(INP(15) + (size_t)l * PLED * DM, DM, 0, 1024, WL + OW_PP, 1280, 1024, MAP_P8, 0, scr, r, F.lane); continue; } r -= I_P;
            wconv_item(INP(16) + (size_t)l * DM * DM, DM, 0, 1024, WL + OW_PP, 1280, 0, MAP_P8, 0, scr, r, F.lane);
        }
        __syncthreads();
        pass_t0(F, INP(0), INP(2), INP(3), INP(4), WSB(WS_XN), WSF(WS_LS), (unsigned char*)OUTP() + OUT_XN8);
    }
    PH_END(true)

    for (int l = 0; l < DEPTH; ++l) {
        PH_BEGIN
        {
            scan_phase(F, WSF(WS_LS), WSF(WS_BIASC), WSB(WS_BIASK));
            pg8::Prob<1, 1024, 1024, 12, 0, 0, 0, 16, 16, 16> P{WSB(WS_XN), WLAYER(l) + OW_IN, F.G, F.bid};
            pg8::EpiQKV E{WSB(WS_Q), WSB(WS_K), WSB(WS_V), WSF(WS_TAB), WSF(WS_KMP), (unsigned*)(WSP() + WS_CTL) + CW_STAT + 64 * l};
            pg8::gemm_phase(F.lds + RING_OFF, P, E);
        }
        PH_END(true)
        PH_BEGIN
        {
            unsigned* qctr = (unsigned*)(WSP() + WS_CTL) + CW_Q + 64 * 8 * 3 * l;
            attn_l2a(F, (char*)lds + RING_OFF, qctr, WSB(WS_Q), WSB(WS_K), WSB(WS_V), WSB(WS_BIASK), WSF(WS_BIASC), (const unsigned*)(WSP() + WS_CTL) + CW_STAT + 64 * l, WSF(WS_KMP),
                     (unsigned*)(WSP() + WS_CTL) + CW_LCNT + 1024 * l, (unsigned short*)((unsigned char*)OUTP() + OUT_LIST), (float*)((unsigned char*)OUTP() + OUT_PL), WSB(WS_Y), WSB(WS_OD), WSF(WS_LSE));
        }
        PH_END(true)
#if ROUTED_MOBA
        PH_BEGIN
        moba_routed_pass(F, (char*)lds + RING_OFF, (unsigned*)(WSP() + WS_CTL) + CW_RQ + 64 * l, (const unsigned*)(WSP() + WS_CTL) + CW_LCNT + 1024 * l,
                         (const unsigned short*)((unsigned char*)OUTP() + OUT_LIST), WSB(WS_Q), WSB(WS_K), WSB(WS_V), WSB(WS_PO), (float*)((unsigned char*)OUTP() + OUT_PL));
        PH_END(true)
#endif
        PH_BEGIN
        {
#if FAST_DIL
            dil_merge(F, WSB(WS_OD), WSF(WS_LSE), WSB(WS_Y));
#endif
#if ROUTED_MOBA
            moba_combine(F, WSB(WS_PO), (const float*)((unsigned char*)OUTP() + OUT_PL), WSB(WS_Y));
#endif
        }
        PH_END(true)
        PH_BEGIN
        {
            bf16* gs = WSB(WS_GATES) + (size_t)F.bid * 393216;
            { pg8::Prob<3, 512, 512, 4, 0, 0, 0, 8, 8, 8, 1024, true> P{(const bf16*)((unsigned char*)OUTP() + OUT_XN8), WLAYER(l) + OW_IN + (size_t)3072 * 1024, F.G, F.bid};
              pg8::EpiGateS E{gs, 1.0f / 64.0f}; pg8::gemm_phase(F.lds + RING_OFF, P, E); }
            { pg8::Prob<3, 1024, 1024, 4, 0, 256, 384, 4, 2, 6> P{WSB(WS_Y), WLAYER(l) + OW_BR, F.G, F.bid};
              pg8::EpiMergeS E{gs, WSB(WS_MERGED)}; pg8::gemm_phase(F.lds + RING_OFF, P, E); }
        }
        PH_END(true)
        PH_BEGIN
        {
            pg8::Prob<1, 1024, 1024, 4, 0, 0, 0, 16, 16, 16> P{WSB(WS_MERGED), WLAYER(l) + OW_OUT, F.G, F.bid};
            pg8::EpiPlain E{WSB(WS_Y3), 1024};
            pg8::gemm_phase(F.lds + RING_OFF, P, E);
        }
        PH_END(true)
        PH_BEGIN
        if (l == 0) pass_res<1, true, false>(F, WSB(WS_Y3), INP(0), DM, OUTP(), DM, INP(9) + l * DM, INP(10) + l * DM, WSB(WS_XN), 1024, nullptr, nullptr, nullptr, nullptr);
        else pass_res<1, false, false>(F, WSB(WS_Y3), OUTP(), DM, OUTP(), DM, INP(9) + l * DM, INP(10) + l * DM, l >= FP8_UP_FROM_LAYER ? nullptr : WSB(WS_XN), 1024, nullptr, nullptr, nullptr, nullptr, l >= FP8_UP_FROM_LAYER ? (unsigned char*)OUTP() + OUT_XN8 : nullptr);
        PH_END(true)
        PH_BEGIN
        {
            if (l >= FP8_UP_FROM_LAYER) { pg8::Prob<1, 512, 512, 22, 0, 0, 0, 8, 8, 8, 0, true> P{(const bf16*)((unsigned char*)OUTP() + OUT_XN8), WLAYER(l) + OW_GU, F.G, F.bid};
                if (l >= FP8_DOWN_FROM_LAYER) { pg8::EpiSwiGLU8 E{(unsigned char*)WSB(WS_FF), DFF, 1.0f / 64.0f}; pg8::gemm_phase(F.lds + RING_OFF, P, E); }
                else { pg8::EpiSwiGLU E{WSB(WS_FF), DFF, 1.0f / 64.0f}; pg8::gemm_phase(F.lds + RING_OFF, P, E); } }
            else { pg8::Prob<1, 1024, 1024, 22, 0, 0, 0, 16, 16, 16> P{WSB(WS_XN), WLAYER(l) + OW_GU, F.G, F.bid};
                if (l >= FP8_DOWN_FROM_LAYER) { pg8::EpiSwiGLU8 E{(unsigned char*)WSB(WS_FF), DFF, 1.0f}; pg8::gemm_phase(F.lds + RING_OFF, P, E); }
                else { pg8::EpiSwiGLU E{WSB(WS_FF), DFF, 1.0f}; pg8::gemm_phase(F.lds + RING_OFF, P, E); } }
        }
        PH_END(true)
        PH_BEGIN
        {
            if (l >= FP8_DOWN_FROM_LAYER) { pg8::Prob<1, DFF / 2, DFF / 2, 4, 0, 0, 0, 22, 22, 22, 0, true> P{WSB(WS_FF), WLAYER(l) + OW_DN, F.G, F.bid};
                pg8::EpiScaled E{WSB(WS_Y3), 1024, 1.0f / 256.0f}; pg8::gemm_phase(F.lds + RING_OFF, P, E); }
            else { pg8::Prob<1, DFF, DFF, 4, 0, 0, 0, 44, 44, 44> P{WSB(WS_FF), WLAYER(l) + OW_DN, F.G, F.bid}; pg8::EpiPlain E{WSB(WS_Y3), 1024}; pg8::gemm_phase(F.lds + RING_OFF, P, E); }
        }
        PH_END(true)
        PH_BEGIN
        pass_res<2, false, false>(F, WSB(WS_Y3), OUTP(), DM, WSB(WS_XBP), 1280, INP(14) + l * DM, nullptr, nullptr, 0, nullptr, nullptr, nullptr, INP(1) + (size_t)l * M * PLED);
        PH_END(true)
        PH_BEGIN
        {
            pg8::Prob<2, 1280, 1280, 4, 1024, 0, 0, 4, 16, 16> P{WSB(WS_XBP), WLAYER(l) + OW_PP, F.G, F.bid};
            pg8::EpiPLE E{WSB(WS_TSCR) + (size_t)F.bid * 65536, WSB(WS_Y3)};
            pg8::gemm_phase(F.lds + RING_OFF, P, E);
        }
        PH_END(true)
        PH_BEGIN
        if (l + 1 < DEPTH) pass_res<1, false, false>(F, WSB(WS_Y3), WSB(WS_XBP), 1280, OUTP(), DM, INP(17) + l * DM, INP(2) + (l + 1) * DM, WSB(WS_XN), 1024, INP(3) + (size_t)(l + 1) * DM * WINC, INP(4) + (l + 1) * 4, WSF(WS_LS), nullptr, (unsigned char*)OUTP() + OUT_XN8);
        else pass_res<0, false, true>(F, WSB(WS_Y3), WSB(WS_XBP), 1280, OUTP(), DM, INP(17) + l * DM, nullptr, nullptr, 0, nullptr, nullptr, nullptr, nullptr);
        PH_END(l + 1 < DEPTH)
    }
#undef PH_BEGIN
#undef PH_END
}

extern "C" void kernel_launch(void* const* d_in, const int* in_sizes, int n_in, void* d_out, int out_size, void* d_ws, size_t ws_size, hipStream_t stream) {
    static int grid = 0;
    if (grid == 0) {
        if (n_in != 18 || out_size != M * DM || ws_size < WS_END) { fprintf(stderr, "kernel_launch: unexpected shapes (n_in %d out %d ws %zu)\n", n_in, out_size, ws_size); grid = -1; return; }
        int dev = 0, cus = 0, per_cu = 0;
        if (hipGetDevice(&dev) != hipSuccess || hipDeviceGetAttribute(&cus, hipDeviceAttributeMultiprocessorCount, dev) != hipSuccess) { grid = -1; return; }
        if (hipFuncSetAttribute((const void*)fwd_kernel, hipFuncAttributeMaxDynamicSharedMemorySize, LDS_BYTES) != hipSuccess) { grid = -1; return; }
        if (hipOccupancyMaxActiveBlocksPerMultiprocessor(&per_cu, (const void*)fwd_kernel, NWAVES * 64, LDS_BYTES) != hipSuccess || per_cu < 1) { fprintf(stderr, "kernel_launch: occupancy query says %d\n", per_cu); }
        (void)hipGetLastError();
        grid = cus;
    }
    if (grid < 0) return;
    (void)hipMemsetAsync((char*)d_ws + WS_CTL, 0, CTL_ZERO_BYTES, stream);
    Args a{};
    for (int i = 0; i < 18; ++i) a.in[i] = (const float*)d_in[i];
    a.out = (float*)d_out; a.ws = (unsigned char*)d_ws; a.ph_lo = 0; a.ph_hi = 1000;
    hipLaunchKernelGGL(fwd_kernel, dim3(grid), dim3(NWAVES * 64), LDS_BYTES, stream, a);
}
```
